# Optimizing an MI355X kernel written in HIP

```python
import math
import jax, jax.numpy as jnp
from jax import lax
import numpy as np

D_MODEL = 1024
BATCH = 32
SEQ = 2048
DEPTH = 1

HEAD_DIM = 64
SB_HEADS = 8
DIL_GROUPS = ((128, 1), (512, 4), (2048, 16))
DIL_HEADS = 4
MEM_HEADS = 4
MEM_HEAD_DIM = 128
MEM_LEN = 256
N_BRANCHES = 3
D_FF = ((-(-8 * D_MODEL // 3) + 255) // 256) * 256
BLOCK = 128
ROPE_THETA = 10000.0
NORM_EPS = 1e-6
NEG_INF = -1e30

SB_W = SB_HEADS * HEAD_DIM
DIL_W = DIL_HEADS * HEAD_DIM
MEM_W = MEM_HEADS * MEM_HEAD_DIM
IN_SPLITS = (SB_W,) * 3 + (DIL_W,) * (3 * len(DIL_GROUPS)) + (MEM_W,)
D_IN = sum(IN_SPLITS)

kernel_name = 'hybrid_stickbreak_dilated_memory_block'


def rms_norm(x, g):
    xf = x.astype(jnp.float32)
    y = xf * lax.rsqrt(jnp.mean(xf * xf, axis=-1, keepdims=True) + NORM_EPS)
    return (y * g.astype(jnp.float32)).astype(x.dtype)


def rope(x, pos):
    dh = x.shape[-1]
    half = dh // 2
    inv_freq = ROPE_THETA ** (-jnp.arange(half, dtype=jnp.float32) * 2.0 / dh)
    ang = pos.astype(jnp.float32)[:, None] * inv_freq[None, :]
    cos = jnp.cos(ang)[None, :, None, :]
    sin = jnp.sin(ang)[None, :, None, :]
    xf = x.astype(jnp.float32)
    x1, x2 = xf[..., :half], xf[..., half:]
    return jnp.concatenate([x1 * cos - x2 * sin, x2 * cos + x1 * sin], axis=-1).astype(x.dtype)


def stick_breaking_attention(q, k, v):
    B, S, H, dh = q.shape
    scale = dh ** -0.5
    outs = []
    for i in range(S // BLOCK):
        t0 = i * BLOCK
        t1 = t0 + BLOCK
        z = jnp.einsum('bqhd,bkhd->bhqk', q[:, t0:t1], k[:, :t1]).astype(jnp.float32) * scale
        t_pos = t0 + jnp.arange(BLOCK)[:, None]
        s_pos = jnp.arange(t1)[None, :]
        causal = s_pos < t_pos
        log_beta = jax.nn.log_sigmoid(z)
        log_keep = jnp.where(causal, jax.nn.log_sigmoid(-z), 0.0)
        log_keep_after = lax.cumsum(log_keep, axis=3, reverse=True) - log_keep
        weight = jnp.where(causal, jnp.exp(log_beta + log_keep_after), 0.0)
        outs.append(jnp.einsum('bhqk,bkhd->bqhd', weight, v[:, :t1].astype(jnp.float32)))
    return jnp.concatenate(outs, axis=1).astype(q.dtype)


def banded_attention(q, k, v, span):
    N, L, H, dh = q.shape
    nb = -(-L // BLOCK)
    pad = nb * BLOCK - L
    padf = lambda t: jnp.pad(t, ((0, 0), (0, pad), (0, 0), (0, 0))).reshape(N, nb, BLOCK, H, dh)
    qb, kb, vb = padf(q), padf(k), padf(v)
    prev = lambda t: jnp.concatenate([jnp.zeros_like(t[:, :1]), t[:, :-1]], axis=1)
    kk = jnp.concatenate([prev(kb), kb], axis=2)
    vv = jnp.concatenate([prev(vb), vb], axis=2)
    s = jnp.einsum('nbqhd,nbkhd->nbhqk', qb, kk).astype(jnp.float32) * (dh ** -0.5)
    qi = jnp.arange(BLOCK)[:, None] + BLOCK
    kj = jnp.arange(2 * BLOCK)[None, :]
    dist = qi - kj
    band = (dist >= 0) & (dist <= span)
    has_prev = (jnp.arange(nb)[:, None, None] > 0) | (kj[None] >= BLOCK)
    valid = band[None] & has_prev
    s = jnp.where(valid[None, :, None], s, NEG_INF)
    m = jnp.max(s, axis=-1, keepdims=True)
    p = jnp.exp(s - m)
    den = jnp.sum(p, axis=-1, keepdims=True)
    o = jnp.einsum('nbhqk,nbkhd->nbhqd', p, vv.astype(jnp.float32)) / den
    lse = (m + jnp.log(den))[..., 0]
    o = o.transpose(0, 1, 3, 2, 4).reshape(N, nb * BLOCK, H, dh)[:, :L]
    lse = lse.transpose(0, 1, 3, 2).reshape(N, nb * BLOCK, H)[:, :L]
    return o, lse


def dilated_window_attention(q, k, v, window, dilation):
    B, S, H, dh = q.shape
    L = S // dilation
    def to_sub(t):
        return t.reshape(B, L, dilation, H, dh).transpose(0, 2, 1, 3, 4).reshape(B * dilation, L, H, dh)
    o, lse = banded_attention(to_sub(q), to_sub(k), to_sub(v), window // dilation)
    o = o.reshape(B, dilation, L, H, dh).transpose(0, 2, 1, 3, 4).reshape(B, S, H, dh)
    lse = lse.reshape(B, dilation, L, H).transpose(0, 2, 1, 3).reshape(B, S, H)
    return o, lse


def memory_cross_attention(q, k, v):
    s = jnp.einsum('bshd,bmhd->bhsm', q, k).astype(jnp.float32) * (q.shape[-1] ** -0.5)
    p = jax.nn.softmax(s, axis=-1)
    return jnp.einsum('bhsm,bmhd->bshd', p, v.astype(jnp.float32)).astype(q.dtype)


def setup_inputs(seed: int = 0) -> dict:
    key = jax.random.key(seed)
    ks = jax.random.split(key, 20)
    def w(k, shape, fan_in):
        return jax.random.normal(k, shape, jnp.float32) * (fan_in ** -0.5)
    def gain(k):
        return 1.0 + 0.05 * jax.random.normal(k, (DEPTH, D_MODEL), jnp.float32)
    return {
        'x': jax.random.normal(ks[0], (BATCH, SEQ, D_MODEL), jnp.float32),
        'mem': jax.random.normal(ks[1], (BATCH, MEM_LEN, D_MODEL), jnp.float32),
        'g_pre_mix': gain(ks[2]),
        'g_post_mix': gain(ks[3]),
        'g_pre_ffn': gain(ks[4]),
        'g_post_ffn': gain(ks[5]),
        'g_mem': gain(ks[6]),
        'w_in': w(ks[7], (DEPTH, D_MODEL, D_IN), D_MODEL),
        'w_mem_kv': w(ks[8], (DEPTH, D_MODEL, 2 * MEM_W), D_MODEL),
        'w_br_sb': w(ks[9], (DEPTH, SB_W, D_MODEL), SB_W),
        'w_br_dil': w(ks[10], (DEPTH, DIL_W, D_MODEL), DIL_W),
        'w_br_mem': w(ks[11], (DEPTH, MEM_W, D_MODEL), MEM_W),
        'w_gate': w(ks[12], (DEPTH, D_MODEL, N_BRANCHES * D_MODEL), D_MODEL),
        'b_gate': 0.02 * jax.random.normal(ks[13], (DEPTH, N_BRANCHES * D_MODEL), jnp.float32),
        'w_o': w(ks[14], (DEPTH, D_MODEL, D_MODEL), D_MODEL),
        'w_ffn_in': w(ks[15], (DEPTH, D_MODEL, 2 * D_FF), D_MODEL),
        'w_ffn_out': w(ks[16], (DEPTH, D_FF, D_MODEL), D_FF),
    }


def reference(x, mem, g_pre_mix, g_post_mix, g_pre_ffn, g_post_ffn, g_mem, w_in, w_mem_kv,
              w_br_sb, w_br_dil, w_br_mem, w_gate, b_gate, w_o, w_ffn_in, w_ffn_out):
    B, S, D = x.shape
    pos = jnp.arange(S)
    split_idx = [int(i) for i in np.cumsum(IN_SPLITS)[:-1]]
    n_g = len(DIL_GROUPS)
    for l in range(DEPTH):
        h = rms_norm(x, g_pre_mix[l])
        proj = jnp.einsum('bsd,de->bse', h, w_in[l])
        parts = jnp.split(proj, split_idx, axis=-1)
        heads = lambda t, n, dh: t.reshape(B, S, n, dh)

        q_a, k_a, v_a = (heads(t, SB_HEADS, HEAD_DIM) for t in parts[0:3])
        o_a = stick_breaking_attention(q_a, k_a, v_a).reshape(B, S, SB_W)

        outs, lses = [], []
        for g, (window, dilation) in enumerate(DIL_GROUPS):
            q_g, k_g, v_g = (heads(t, DIL_HEADS, HEAD_DIM) for t in parts[3 + 3 * g: 6 + 3 * g])
            o_g, lse_g = dilated_window_attention(rope(q_g, pos), rope(k_g, pos), v_g, window, dilation)
            outs.append(o_g)
            lses.append(lse_g)
        alpha = jax.nn.softmax(jnp.stack(lses, axis=0), axis=0)[..., None]
        o_b = jnp.sum(alpha * jnp.stack(outs, axis=0), axis=0).astype(x.dtype).reshape(B, S, DIL_W)

        q_c = heads(parts[3 + 3 * n_g], MEM_HEADS, MEM_HEAD_DIM)
        kv_m = jnp.einsum('bmd,de->bme', rms_norm(mem, g_mem[l]), w_mem_kv[l])
        k_m = kv_m[..., :MEM_W].reshape(B, MEM_LEN, MEM_HEADS, MEM_HEAD_DIM)
        v_m = kv_m[..., MEM_W:].reshape(B, MEM_LEN, MEM_HEADS, MEM_HEAD_DIM)
        o_c = memory_cross_attention(q_c, k_m, v_m).reshape(B, S, MEM_W)

        y_a = jnp.einsum('bse,ed->bsd', o_a, w_br_sb[l])
        y_b = jnp.einsum('bse,ed->bsd', o_b, w_br_dil[l])
        y_c = jnp.einsum('bse,ed->bsd', o_c, w_br_mem[l])
        gates = jax.nn.sigmoid(jnp.einsum('bsd,de->bse', h, w_gate[l]) + b_gate[l]).reshape(B, S, N_BRANCHES, D)
        merged = gates[:, :, 0] * y_a + gates[:, :, 1] * y_b + gates[:, :, 2] * y_c
        mix = jnp.einsum('bsd,de->bse', merged, w_o[l])
        x = x + rms_norm(mix, g_post_mix[l])

        h2 = rms_norm(x, g_pre_ffn[l])
        gu = jnp.einsum('bsd,df->bsf', h2, w_ffn_in[l])
        f = jax.nn.silu(gu[..., :D_FF]) * gu[..., D_FF:]
        f = jnp.einsum('bsf,fd->bsd', f, w_ffn_out[l])
        x = x + rms_norm(f, g_post_ffn[l])
    return x
```

```cpp
#include <hip/hip_runtime.h>
#include <hip/hip_cooperative_groups.h>
#include <cstdio>
#include <cstdint>
namespace cg = cooperative_groups;
namespace pg8 {
#define PG8_LAS __attribute__((address_space(3)))
typedef unsigned short bf16_t;
typedef short bf16x8 __attribute__((ext_vector_type(8)));
typedef float f32x4 __attribute__((ext_vector_type(4)));
typedef unsigned u32x4 __attribute__((ext_vector_type(4)));
constexpr int BM = 256, BK = 64, HALF = 128, HTB = HALF * BK * 2  , STAGE_BYTES = 8 * HTB, NXCD = 8, WGM = 8;

__host__ __device__ __forceinline__ int lds_byte(int r, int c) { const int st = (r >> 4) * 2 + (c >> 5), rr = r & 15, cc = c & 31, ob = rr * 64 + cc * 2; return st * 1024 + (ob ^ (((ob >> 9) & 1) << 5)); }
__host__ __device__ __forceinline__ void stage_rc(int b, int& R, int& C) { const int st = b / 1024, sb = b % 1024, swz = sb ^ (((sb >> 9) & 1) << 5); R = (st >> 1) * 16 + swz / 64; C = (st & 1) * 32 + (swz % 64) / 2; }
__host__ __device__ __forceinline__ int perm32(int rho) { const int n = rho >> 4, i = rho & 15; return 8 * (i >> 2) + 4 * n + (i & 3); }

struct Unit { int pm, pn; const bf16_t* A = nullptr; const bf16_t* Bt = nullptr; int nt = 0, step = 0; };
struct Gemm { const bf16_t* A; const bf16_t* Bt; int M, N, K; int lda = 0, ldb = 0; };

struct StaticOrder {
    int nM, nN, nwg, G, c;
    __host__ __device__ void init(int M, int N, int G_, int c_) { nM = M / BM; nN = N / BM; nwg = nM * nN; G = G_; c = c_; }
    __host__ __device__ bool next(int i, Unit& u) const {
        const long L = (long)i * G + c; if (L >= nwg) return false;
        int wgid = (int)L; { const int q = nwg / NXCD, r = nwg % NXCD, xcd = wgid % NXCD, off = wgid / NXCD; wgid = (xcd < r ? xcd * (q + 1) : r * (q + 1) + (xcd - r) * q) + off; }
        const int nig = WGM * nN, gid = wgid / nig, fm = gid * WGM, gsz = (nM - fm) < WGM ? (nM - fm) : WGM;
        u.pm = fm + ((wgid % nig) % gsz); u.pn = (wgid % nig) / gsz; return true;
    }
    __device__ __forceinline__ void a_ready(const Unit&) const {}
    __device__ __forceinline__ void done(const Unit&) const {}
};

typedef float f32x2 __attribute__((ext_vector_type(2)));
typedef __bf16 pg8_bf16x2 __attribute__((ext_vector_type(2)));
__device__ __forceinline__ unsigned cvt_pk_bf16(float lo, float hi) { f32x2 v = {lo, hi}; pg8_bf16x2 b = __builtin_convertvector(v, pg8_bf16x2); return __builtin_bit_cast(unsigned, b); }
typedef unsigned u32x2 __attribute__((ext_vector_type(2)));
__device__ __forceinline__ float bf_lo(unsigned w) { return __uint_as_float(w << 16); }
__device__ __forceinline__ float bf_hi(unsigned w) { return __uint_as_float(w & 0xffff0000u); }
__device__ __forceinline__ float sigmoidf_fast(float v) { return __builtin_amdgcn_rcpf(1.0f + __builtin_amdgcn_exp2f(-1.4426950408889634f * v)); }
__device__ __forceinline__ u32x4 pack8(const f32x4 v0, const f32x4 v1) { u32x4 w; w.x = cvt_pk_bf16(v0[0], v0[1]); w.y = cvt_pk_bf16(v0[2], v0[3]); w.z = cvt_pk_bf16(v1[0], v1[1]); w.w = cvt_pk_bf16(v1[2], v1[3]); return w; }

__device__ __forceinline__ u32x4 ld16_agent(const bf16_t* p) { const unsigned long long* q = (const unsigned long long*)p;
    const unsigned long long a = __hip_atomic_load(q, __ATOMIC_RELAXED, __HIP_MEMORY_SCOPE_AGENT), b = __hip_atomic_load(q + 1, __ATOMIC_RELAXED, __HIP_MEMORY_SCOPE_AGENT);
    u32x4 r; r.x = (unsigned)a; r.y = (unsigned)(a >> 32); r.z = (unsigned)b; r.w = (unsigned)(b >> 32); return r; }
struct EpiPlain {
    static constexpr bool PERM = true, AFTER_DRAIN = false;
    bf16_t* O; int ldc;
    __device__ __forceinline__ void operator()(const f32x4 (&acc)[2][2][4][2], const Unit& u, int wr, int wc, int fr, int fq) const {
        const int row0 = u.pm * BM + wr * 64 + fr, col0 = u.pn * BM + wc * 32 + 8 * fq;
#pragma unroll
        for (int ai = 0; ai < 2; ++ai)
#pragma unroll
            for (int m = 0; m < 4; ++m) { bf16_t* rowp = O + (size_t)(row0 + ai * HALF + m * 16) * ldc + col0;
#pragma unroll
                for (int bj = 0; bj < 2; ++bj) *(u32x4*)(rowp + bj * HALF) = pack8(acc[ai][bj][m][0], acc[ai][bj][m][1]); }
    }
};
constexpr size_t SZ64 = 33554432ull, SZ32 = 16777216ull;
__device__ __forceinline__ size_t proj_off(int pn, int row, int cl) {
    const int b = row >> 11, s = row & 2047;
    if (pn < 6) { const int kind = pn >> 1, c = (pn & 1) * 256 + cl, hh = c >> 6, dd = c & 63; return (size_t)kind * SZ64 + ((size_t)(b * 8 + hh) * 2048 + s) * 64 + dd; }
    if (pn < 15) { const int gk = pn - 6, g = gk / 3, hh = cl >> 6, dd = cl & 63, sh = 2 * g, rho = s & ((1 << sh) - 1), n = s >> sh, L = 2048 >> sh;
        return 3 * SZ64 + (size_t)gk * SZ32 + ((size_t)(b * 4 + hh) * 2048 + rho * L + n) * 64 + dd; }
    { const int c = (pn - 15) * 256 + cl, hh = c >> 7, dd = c & 127; return 3 * SZ64 + 9 * SZ32 + ((size_t)(b * 4 + hh) * 2048 + s) * 128 + dd; }
}
struct EpiProj {
    static constexpr bool PERM = true, AFTER_DRAIN = false;
    bf16_t* O; const float* rope;
    __device__ __forceinline__ void operator()(const f32x4 (&acc)[2][2][4][2], const Unit& u, int wr, int wc, int fr, int fq) const {
        const int pn = u.pn;
        const int dg = pn - 6;
        const bool dil = (dg >= 0 && dg < 9);
        const bool is_rope = dil && (dg % 3) != 2;
        const float sc = (pn < 2 || (dil && (dg % 3) == 0)) ? 0.125f : 1.0f;
        const int row0 = u.pm * BM + wr * 64 + fr, cl0 = wc * 32 + 8 * fq;
#pragma unroll
        for (int ai = 0; ai < 2; ++ai)
#pragma unroll
            for (int m = 0; m < 4; ++m) { const int row = row0 + ai * HALF + m * 16; const int pos = row & 2047;
                const size_t po = proj_off(pn, row, cl0);
#pragma unroll
                for (int bj = 0; bj < 2; ++bj) { f32x4 v0 = acc[ai][bj][m][0], v1 = acc[ai][bj][m][1];
                    if (is_rope) { const int jb = ((cl0 + bj * HALF) & 63) >> 1;
                        const f32x4 c0 = *(const f32x4*)(rope + (size_t)(pos * 32 + jb) * 2), c1 = *(const f32x4*)(rope + (size_t)(pos * 32 + jb + 2) * 2);
                        f32x4 t0, t1;
                        t0[0] = v0[0] * c0[0] - v0[1] * c0[1]; t0[1] = v0[1] * c0[0] + v0[0] * c0[1]; t0[2] = v0[2] * c0[2] - v0[3] * c0[3]; t0[3] = v0[3] * c0[2] + v0[2] * c0[3];
                        t1[0] = v1[0] * c1[0] - v1[1] * c1[1]; t1[1] = v1[1] * c1[0] + v1[0] * c1[1]; t1[2] = v1[2] * c1[2] - v1[3] * c1[3]; t1[3] = v1[3] * c1[2] + v1[2] * c1[3];
                        v0 = t0; v1 = t1; }
                    v0 = v0 * sc; v1 = v1 * sc;
                    *(u32x4*)(O + po + (size_t)bj * 262144) = pack8(v0, v1); } }
    }
};
struct EpiGate {
    static constexpr bool PERM = true, AFTER_DRAIN = false;
    bf16_t* O; const float* bias;
    __device__ __forceinline__ void operator()(const f32x4 (&acc)[2][2][4][2], const Unit& u, int wr, int wc, int fr, int fq) const {
        const int row0 = u.pm * BM + wr * 64 + fr, col0 = u.pn * BM + wc * 32 + 8 * fq;
        f32x4 bv[2][2];
#pragma unroll
        for (int bj = 0; bj < 2; ++bj)
#pragma unroll
            for (int n = 0; n < 2; ++n) bv[bj][n] = *(const f32x4*)(bias + col0 + bj * HALF + 4 * n);
#pragma unroll
        for (int ai = 0; ai < 2; ++ai)
#pragma unroll
            for (int m = 0; m < 4; ++m) { bf16_t* rowp = O + (size_t)(row0 + ai * HALF + m * 16) * 1024 + col0;
#pragma unroll
                for (int bj = 0; bj < 2; ++bj) { f32x4 v0 = acc[ai][bj][m][0] + bv[bj][0], v1 = acc[ai][bj][m][1] + bv[bj][1];
#pragma unroll
                    for (int e = 0; e < 4; ++e) { v0[e] = sigmoidf_fast(v0[e]); v1[e] = sigmoidf_fast(v1[e]); }
                    *(u32x4*)(rowp + bj * HALF) = pack8(v0, v1); } }
    }
};
template <bool FIRST> struct EpiBranch {
    static constexpr bool PERM = true, AFTER_DRAIN = false;
    bf16_t* MG; const bf16_t* GS;
    __device__ __forceinline__ void operator()(const f32x4 (&acc)[2][2][4][2], const Unit& u, int wr, int wc, int fr, int fq) const {
        const int row0 = u.pm * BM + wr * 64 + fr, col0 = u.pn * BM + wc * 32 + 8 * fq;
#pragma unroll
        for (int ai = 0; ai < 2; ++ai)
#pragma unroll
            for (int m = 0; m < 4; ++m) { const size_t off = (size_t)(row0 + ai * HALF + m * 16) * 1024 + col0;
#pragma unroll
                for (int bj = 0; bj < 2; ++bj) { const u32x4 g = ld16_agent(GS + off + bj * HALF);
                    f32x4 v0 = acc[ai][bj][m][0], v1 = acc[ai][bj][m][1];
                    v0[0] *= bf_lo(g.x); v0[1] *= bf_hi(g.x); v0[2] *= bf_lo(g.y); v0[3] *= bf_hi(g.y);
                    v1[0] *= bf_lo(g.z); v1[1] *= bf_hi(g.z); v1[2] *= bf_lo(g.w); v1[3] *= bf_hi(g.w);
                    if (!FIRST) { const u32x4 p = ld16_agent(MG + off + bj * HALF);
                        v0[0] += bf_lo(p.x); v0[1] += bf_hi(p.x); v0[2] += bf_lo(p.y); v0[3] += bf_hi(p.y);
                        v1[0] += bf_lo(p.z); v1[1] += bf_hi(p.z); v1[2] += bf_lo(p.w); v1[3] += bf_hi(p.w); }
                    *(u32x4*)(MG + off + bj * HALF) = pack8(v0, v1); } }
    }
};
struct EpiSwiglu {
    static constexpr bool PERM = true, AFTER_DRAIN = false;
    bf16_t* O;
    __device__ __forceinline__ void operator()(const f32x4 (&acc)[2][2][4][2], const Unit& u, int wr, int wc, int fr, int fq) const {
        const int row0 = u.pm * BM + wr * 64 + fr, col0 = u.pn * HALF + wc * 32 + 8 * fq;
#pragma unroll
        for (int ai = 0; ai < 2; ++ai)
#pragma unroll
            for (int m = 0; m < 4; ++m) { bf16_t* rowp = O + (size_t)(row0 + ai * HALF + m * 16) * 2816 + col0;
                f32x4 v0, v1;
#pragma unroll
                for (int e = 0; e < 4; ++e) { const float g0 = acc[ai][0][m][0][e], g1 = acc[ai][0][m][1][e];
                    v0[e] = g0 * sigmoidf_fast(g0) * acc[ai][1][m][0][e]; v1[e] = g1 * sigmoidf_fast(g1) * acc[ai][1][m][1][e]; }
                *(u32x4*)rowp = pack8(v0, v1); }
    }
};

struct P3Order {
    StaticOrder S; const bf16_t* xnp; const bf16_t* oabc; const bf16_t* wcat;
    __device__ __forceinline__ bool next(int i, Unit& u) const {
        if (!S.next(i / 6, u)) return false;
        const int st = i % 6, br = st >> 1; u.step = st;
        if (st & 1) { u.A = xnp; u.Bt = wcat + br * 1024; u.nt = 16; }
        else { const int co = (br == 0) ? 0 : (br == 1 ? 512 : 768); u.A = oabc + co; u.Bt = wcat + 3072 + co; u.nt = (br == 1) ? 4 : 8; }
        return true;
    }
    __device__ __forceinline__ void a_ready(const Unit&) const {}
    __device__ __forceinline__ void done(const Unit&) const {}
};
struct EpiP3 {
    static constexpr bool PERM = true, AFTER_DRAIN = false;
    bf16_t* YS; bf16_t* MG; const float* bias;
    __device__ __forceinline__ void operator()(const f32x4 (&acc)[2][2][4][2], const Unit& u, int wr, int wc, int fr, int fq) const {
        const int row0 = u.pm * BM + wr * 64 + fr, col0 = u.pn * BM + wc * 32 + 8 * fq;
        if ((u.step & 1) == 0) {
#pragma unroll
            for (int ai = 0; ai < 2; ++ai)
#pragma unroll
                for (int m = 0; m < 4; ++m) { bf16_t* rowp = YS + (size_t)(row0 + ai * HALF + m * 16) * 1024 + col0;
#pragma unroll
                    for (int bj = 0; bj < 2; ++bj) *(u32x4*)(rowp + bj * HALF) = pack8(acc[ai][bj][m][0], acc[ai][bj][m][1]); }
        } else {
            const int br = u.step >> 1; const bool first = (br == 0);
            f32x4 bv[2][2];
#pragma unroll
            for (int bj = 0; bj < 2; ++bj)
#pragma unroll
                for (int n = 0; n < 2; ++n) bv[bj][n] = *(const f32x4*)(bias + br * 1024 + col0 + bj * HALF + 4 * n);
#pragma unroll
            for (int ai = 0; ai < 2; ++ai)
#pragma unroll
                for (int m = 0; m < 4; ++m) { const size_t off = (size_t)(row0 + ai * HALF + m * 16) * 1024 + col0;
#pragma unroll
                    for (int bj = 0; bj < 2; ++bj) { const u32x4 y = *(const u32x4*)(YS + off + bj * HALF);
                        f32x4 v0 = acc[ai][bj][m][0] + bv[bj][0], v1 = acc[ai][bj][m][1] + bv[bj][1];
#pragma unroll
                        for (int e = 0; e < 4; ++e) { v0[e] = sigmoidf_fast(v0[e]); v1[e] = sigmoidf_fast(v1[e]); }
                        v0[0] *= bf_lo(y.x); v0[1] *= bf_hi(y.x); v0[2] *= bf_lo(y.y); v0[3] *= bf_hi(y.y);
                        v1[0] *= bf_lo(y.z); v1[1] *= bf_hi(y.z); v1[2] *= bf_lo(y.w); v1[3] *= bf_hi(y.w);
                        if (!first) { const u32x4 p = *(const u32x4*)(MG + off + bj * HALF);
                            v0[0] += bf_lo(p.x); v0[1] += bf_hi(p.x); v0[2] += bf_lo(p.y); v0[3] += bf_hi(p.y);
                            v1[0] += bf_lo(p.z); v1[1] += bf_hi(p.z); v1[2] += bf_lo(p.w); v1[3] += bf_hi(p.w); }
                        *(u32x4*)(MG + off + bj * HALF) = pack8(v0, v1); } }
        }
    }
};
template <class Epi, class Sched, bool ALIGN_EPI = false, bool SP2 = false, bool MULTI = false>
__device__ __forceinline__ void gemm_phase(PG8_LAS unsigned char* lds, const Gemm g, const Sched& S, const Epi& E) {
    int tid_ = threadIdx.x; asm volatile("" : "+v"(tid_));
    const int tid = tid_, wid = __builtin_amdgcn_readfirstlane(tid >> 6), lane = tid & 63, wr = wid >> 2, wc = wid & 3, fr = lane & 15, fq = lane >> 4;
    const int lda = g.lda ? g.lda : g.K, ldb = g.ldb ? g.ldb : g.K; int nt = g.K / BK;
    unsigned voffA[2], voffB[2];
#pragma unroll
    for (int i = 0; i < 2; ++i) { int R, C; stage_rc(tid * 16 + i * 8192, R, C); const int Rb = Epi::PERM ? ((R & ~31) + perm32(R & 31)) : R;
        voffA[i] = (unsigned)(R * lda + C) * 2u; voffB[i] = (unsigned)(Rb * ldb + C) * 2u; }
    const size_t kstep = (size_t)(BK * 2);
    const size_t hstepA = (size_t)HALF * lda * 2, hstepB = (size_t)HALF * ldb * 2;
    const size_t tstepA = 2 * hstepA, tstepB = 2 * hstepB;
    const unsigned ldsw = (unsigned)wid * 1024u;
    const int aoff = lds_byte(wr * 64 + fr, fq * 8), boff = lds_byte(wc * 32 + fr, fq * 8);
#define PG8_SA(b, h) (((b) * 2 + (h)) * HTB)
#define PG8_SB(b, h) ((4 + (b) * 2 + (h)) * HTB)
#define PG8_STAGE(bufoff, gbase, voff) do { _Pragma("unroll") for (int _i = 0; _i < 2; ++_i) \
        __builtin_amdgcn_global_load_lds((const unsigned*)((const char*)(gbase) + (voff)[_i]), (PG8_LAS unsigned*)(lds + (bufoff) + ldsw + _i * 8192), 16, 0, 1); } while (0)
#define PG8_LDA(dst, b, h) do { _Pragma("unroll") for (int m = 0; m < 4; ++m) _Pragma("unroll") for (int k = 0; k < 2; ++k) dst[m][k] = *(const PG8_LAS bf16x8*)(lds + PG8_SA(b, h) + aoff + m * 2048 + k * 1024); } while (0)
#define PG8_LDB(dst, b, h) do { _Pragma("unroll") for (int n = 0; n < 2; ++n) _Pragma("unroll") for (int k = 0; k < 2; ++k) dst[n][k] = *(const PG8_LAS bf16x8*)(lds + PG8_SB(b, h) + boff + n * 2048 + k * 1024); } while (0)
#define PG8_MMA(ai, bj, At, Bt) do { __builtin_amdgcn_s_setprio(1); _Pragma("unroll") for (int m = 0; m < 4; ++m) _Pragma("unroll") for (int n = 0; n < 2; ++n) _Pragma("unroll") for (int k = 0; k < 2; ++k) \
        acc[ai][bj][m][n] = __builtin_amdgcn_mfma_f32_16x16x32_bf16(Bt[n][k], At[m][k], acc[ai][bj][m][n], 0, 0, 0); __builtin_amdgcn_s_setprio(0); } while (0)
#define PG8_WAIT_V(n) asm volatile("s_waitcnt vmcnt(" #n ")" ::: "memory")
#define PG8_WAIT_L(n) asm volatile("s_waitcnt lgkmcnt(" #n ")" ::: "memory")
#define PG8_BAR __builtin_amdgcn_s_barrier()
#define PG8_SCHED __builtin_amdgcn_sched_barrier(0)
    Unit cur, nxt; int ui = 0;
    if (!S.next(0, cur)) return;
    f32x4 acc[2][2][4][2];
#pragma unroll
    for (int a = 0; a < 2; ++a)
#pragma unroll
        for (int b = 0; b < 2; ++b)
#pragma unroll
            for (int m = 0; m < 4; ++m)
#pragma unroll
                for (int n = 0; n < 2; ++n) acc[a][b][m][n] = (f32x4){0.f, 0.f, 0.f, 0.f};
    bf16x8 At[4][2], B0[2][2], B1[2][2];
    if constexpr (MULTI) nt = cur.nt;
    const char* cA = (const char*)(MULTI ? cur.A : g.A) + (size_t)cur.pm * tstepA; const char* cB = (const char*)(MULTI ? cur.Bt : g.Bt) + (size_t)cur.pn * tstepB;
    S.a_ready(cur);
    if constexpr (SP2) {
        PG8_STAGE(PG8_SB(0, 0), cB, voffB); PG8_STAGE(PG8_SB(0, 1), cB + hstepB, voffB); PG8_STAGE(PG8_SA(0, 0), cA, voffA); PG8_STAGE(PG8_SA(0, 1), cA + hstepA, voffA);
        if (wr == 1) PG8_BAR;
        PG8_WAIT_V(2); PG8_BAR;
        PG8_STAGE(PG8_SB(1, 0), cB + kstep, voffB); PG8_STAGE(PG8_SA(1, 0), cA + kstep, voffA); PG8_STAGE(PG8_SB(1, 1), cB + hstepB + kstep, voffB);
        PG8_WAIT_V(6); PG8_BAR;
    } else {
        PG8_STAGE(PG8_SB(0, 0), cB, voffB); PG8_STAGE(PG8_SA(0, 0), cA, voffA); PG8_STAGE(PG8_SB(0, 1), cB + hstepB, voffB); PG8_STAGE(PG8_SA(0, 1), cA + hstepA, voffA);
        if (wr == 1) PG8_BAR;
        PG8_WAIT_V(4); PG8_BAR;
        PG8_STAGE(PG8_SB(1, 0), cB + kstep, voffB); PG8_STAGE(PG8_SA(1, 0), cA + kstep, voffA); PG8_STAGE(PG8_SB(1, 1), cB + hstepB + kstep, voffB);
        PG8_WAIT_V(6); PG8_BAR;
    }
    for (;;) {
        const bool has_next = S.next(ui + 1, nxt);
        const char* nA = has_next ? (const char*)(MULTI ? nxt.A : g.A) + (size_t)nxt.pm * tstepA : cA; const char* nB = has_next ? (const char*)(MULTI ? nxt.Bt : g.Bt) + (size_t)nxt.pn * tstepB : cB;
        for (int t = 0; t < nt; t += 2) {
            const bool last = (t == nt - 2);
            const char* a1 = cA + (size_t)(t + 1) * kstep;
            const char* a2 = last ? nA : cA + (size_t)(t + 2) * kstep; const char* b2 = last ? nB : cB + (size_t)(t + 2) * kstep;
            const char* a3 = a2 + kstep; const char* b3 = b2 + kstep;
            if (last && has_next) S.a_ready(nxt);
            if constexpr (SP2) {
            PG8_LDB(B0, 0, 0); PG8_LDB(B1, 0, 1); PG8_SCHED; PG8_LDA(At, 0, 0); PG8_STAGE(PG8_SA(1, 1), a1 + hstepA, voffA);
            PG8_WAIT_V(8); PG8_WAIT_L(0); PG8_BAR; PG8_MMA(0, 0, At, B0); PG8_MMA(0, 1, At, B1); PG8_BAR; PG8_SCHED;
            PG8_LDA(At, 0, 1); PG8_STAGE(PG8_SB(0, 0), b2, voffB); PG8_STAGE(PG8_SB(0, 1), b2 + hstepB, voffB); PG8_STAGE(PG8_SA(0, 0), a2, voffA);
            PG8_WAIT_V(8); PG8_WAIT_L(0); PG8_BAR; PG8_MMA(1, 0, At, B0); PG8_MMA(1, 1, At, B1); PG8_BAR; PG8_SCHED;
            PG8_LDB(B0, 1, 0); PG8_LDB(B1, 1, 1); PG8_SCHED; PG8_LDA(At, 1, 0); PG8_STAGE(PG8_SA(0, 1), a2 + hstepA, voffA);
            PG8_WAIT_V(8); PG8_WAIT_L(0); PG8_BAR; PG8_MMA(0, 0, At, B0); PG8_MMA(0, 1, At, B1); PG8_BAR; PG8_SCHED;
            PG8_LDA(At, 1, 1); PG8_STAGE(PG8_SB(1, 0), b3, voffB); PG8_STAGE(PG8_SB(1, 1), b3 + hstepB, voffB); PG8_STAGE(PG8_SA(1, 0), a3, voffA);
            PG8_WAIT_V(8); PG8_WAIT_L(0); PG8_BAR; PG8_MMA(1, 0, At, B0); PG8_MMA(1, 1, At, B1); PG8_BAR; PG8_SCHED;
            } else {
            PG8_LDB(B0, 0, 0); PG8_SCHED; PG8_LDA(At, 0, 0); PG8_STAGE(PG8_SA(1, 1), a1 + hstepA, voffA);
            PG8_WAIT_L(8); PG8_BAR; PG8_WAIT_L(0); PG8_MMA(0, 0, At, B0); PG8_BAR; PG8_SCHED;
            PG8_LDB(B1, 0, 1); PG8_STAGE(PG8_SB(0, 0), b2, voffB);
            PG8_BAR; PG8_WAIT_L(0); PG8_MMA(0, 1, At, B1); PG8_BAR;
            PG8_LDA(At, 0, 1); PG8_STAGE(PG8_SA(0, 0), a2, voffA);
            PG8_BAR; PG8_WAIT_L(0); PG8_MMA(1, 0, At, B0); PG8_BAR; PG8_SCHED;
            PG8_STAGE(PG8_SB(0, 1), b2 + hstepB, voffB);
            PG8_WAIT_V(6); PG8_BAR; PG8_MMA(1, 1, At, B1); PG8_BAR;
            PG8_LDB(B0, 1, 0); PG8_SCHED; PG8_LDA(At, 1, 0); PG8_STAGE(PG8_SA(0, 1), a2 + hstepA, voffA);
            PG8_WAIT_L(8); PG8_BAR; PG8_WAIT_L(0); PG8_MMA(0, 0, At, B0); PG8_BAR; PG8_SCHED;
            PG8_LDB(B1, 1, 1); PG8_STAGE(PG8_SB(1, 0), b3, voffB);
            PG8_BAR; PG8_WAIT_L(0); PG8_MMA(0, 1, At, B1); PG8_BAR;
            PG8_LDA(At, 1, 1); PG8_STAGE(PG8_SA(1, 0), a3, voffA);
            PG8_BAR; PG8_WAIT_L(0); PG8_MMA(1, 0, At, B0); PG8_BAR; PG8_SCHED;
            PG8_STAGE(PG8_SB(1, 1), b3 + hstepB, voffB);
            PG8_WAIT_V(6); PG8_BAR; PG8_MMA(1, 1, At, B1); PG8_BAR;
            }
        }
        if constexpr (ALIGN_EPI) { if (wr == 0) PG8_BAR; }
        if constexpr (!Epi::AFTER_DRAIN) { E(acc, cur, wr, wc, fr, fq); S.done(cur); }
        if (!has_next) break;
#pragma unroll
        for (int a = 0; a < 2; ++a)
#pragma unroll
            for (int b = 0; b < 2; ++b)
#pragma unroll
                for (int m = 0; m < 4; ++m)
#pragma unroll
                    for (int n = 0; n < 2; ++n) acc[a][b][m][n] = (f32x4){0.f, 0.f, 0.f, 0.f};
        cur = nxt; cA = nA; cB = nB; ++ui; if constexpr (MULTI) nt = cur.nt;
        if constexpr (ALIGN_EPI) { if (wr == 1) PG8_BAR; }
    }
    PG8_WAIT_V(0);
    if constexpr (!ALIGN_EPI) { if (wr == 0) PG8_BAR; }
    PG8_BAR;
    if constexpr (Epi::AFTER_DRAIN) { E.fused(acc, cur, wr, wc, fr, fq, lds, wid, lane); S.done(cur); }
#undef PG8_SA
#undef PG8_SB
#undef PG8_STAGE
#undef PG8_LDA
#undef PG8_LDB
#undef PG8_MMA
#undef PG8_WAIT_V
#undef PG8_WAIT_L
#undef PG8_BAR
#undef PG8_SCHED
}
}
namespace att {
#define LAS __attribute__((address_space(3)))
typedef unsigned short bf16_t;
typedef short bf16x8 __attribute__((ext_vector_type(8)));
typedef short s16x4 __attribute__((ext_vector_type(4)));
typedef float f32x16 __attribute__((ext_vector_type(16)));
typedef float f32x2 __attribute__((ext_vector_type(2)));
typedef __bf16 bf16x2_t __attribute__((ext_vector_type(2)));
typedef unsigned u32x4 __attribute__((ext_vector_type(4)));
typedef unsigned u32x2 __attribute__((ext_vector_type(2)));
#define MFMA32(a, b, c) __builtin_amdgcn_mfma_f32_32x32x16_bf16((a), (b), (c), 0, 0, 0)
__device__ __forceinline__ int crow(int reg, int h) { return (reg & 3) + 8 * (reg >> 2) + 4 * h; }
__device__ __forceinline__ unsigned cvtpk(float lo, float hi) { f32x2 v = {lo, hi}; bf16x2_t b = __builtin_convertvector(v, bf16x2_t); return __builtin_bit_cast(unsigned, b); }
__device__ __forceinline__ float xhalf(float v, int h) { auto rr = __builtin_amdgcn_permlane32_swap(__float_as_uint(v), __float_as_uint(v), false, false); return __uint_as_float(h ? rr[0] : rr[1]); }
__device__ __forceinline__ float xmax(float v) { auto rr = __builtin_amdgcn_permlane32_swap(__float_as_uint(v), __float_as_uint(v), false, false); return __builtin_fmaxf(__uint_as_float(rr[0]), __uint_as_float(rr[1])); }
__device__ __forceinline__ float xsum(float v) { auto rr = __builtin_amdgcn_permlane32_swap(__float_as_uint(v), __float_as_uint(v), false, false); return __uint_as_float(rr[0]) + __uint_as_float(rr[1]); }
__device__ __forceinline__ s16x4 vtr(const LAS unsigned char* p) { return __builtin_bit_cast(s16x4, __builtin_amdgcn_ds_read_tr16_b64_v4i16((LAS s16x4*)p)); }

__device__ __forceinline__ void store_o32(bf16_t* __restrict__ rowblk, const f32x16& o, float inv, int h) {
#pragma unroll
    for (int gp = 0; gp < 2; ++gp) {
        const unsigned a0 = cvtpk(o[8 * gp] * inv, o[8 * gp + 1] * inv), a1 = cvtpk(o[8 * gp + 2] * inv, o[8 * gp + 3] * inv);
        const unsigned b0 = cvtpk(o[8 * gp + 4] * inv, o[8 * gp + 5] * inv), b1 = cvtpk(o[8 * gp + 6] * inv, o[8 * gp + 7] * inv);
        auto s0 = __builtin_amdgcn_permlane32_swap(a0, b0, false, false);
        auto s1 = __builtin_amdgcn_permlane32_swap(a1, b1, false, false);
        u32x4 w; w.x = s0[0]; w.y = s1[0]; w.z = s0[1]; w.w = s1[1];
        *(u32x4*)(rowblk + 16 * gp + 8 * h) = w; }
}
enum { MODE_XATTN = 0, MODE_BAND = 1, MODE_STICK = 2 };
#define ATT_LOAD_K(KB, KTX, KF) do { const int key0_ = (KTX) * KT; \
        _Pragma("unroll") for (int hf = 0; hf < NH; ++hf) { const unsigned ko = 2u * ((KB) + (unsigned)((key0_ + 32 * hf + r) * DH + 8 * h)); \
            _Pragma("unroll") for (int d0 = 0; d0 < ND; ++d0) KF[hf][d0] = *(const bf16x8*)((const char*)base + (ko + 32u * d0)); } } while (0)
#define ATT_LOAD_V(VB, KTX, VV) do { const int key0_ = (KTX) * KT; \
        _Pragma("unroll") for (int i = 0; i < NCH; ++i) { const int c = i * 64 + lane, row = c / CPR, ch = c % CPR; const int vr = key0_ + row; \
            VV[i] = *(const u32x4*)((const char*)base + 2u * ((VB) + (unsigned)(vr * DH + ch * 8))); } } while (0)
#define ATT_LOAD_Q(QB, N0, QF) do { _Pragma("unroll") for (int d0 = 0; d0 < ND; ++d0) QF[d0] = *(const bf16x8*)((const char*)base + 2u * ((QB) + (unsigned)(((N0) + r) * DH + 16 * d0 + 8 * h))); } while (0)
template <int DH, int KT>
__device__ __forceinline__ void att_prime(const bf16_t* __restrict__ base, unsigned Q, unsigned K, unsigned V, int n0, int kt_hi,
                                          bf16x8 (&qf)[DH / 16], bf16x8 (&kf)[KT / 32][DH / 16], u32x4 (&vv)[KT * (DH / 8) / 64], int lane) {
    constexpr int ND = DH / 16, NH = KT / 32, CPR = DH / 8, NCH = KT * CPR / 64;
    const int r = lane & 31, h = lane >> 5;
    ATT_LOAD_Q(Q, n0, qf); ATT_LOAD_K(K, kt_hi, kf); ATT_LOAD_V(V, kt_hi, vv);
}
template <int DH, int KT, int MODE>
__device__ __forceinline__ void attn_item(const bf16_t* __restrict__ base, unsigned K, unsigned V,
                                          int n0, int kt_hi, int kt_lo, float sscale, bf16_t* __restrict__ O, long o_rs, float* __restrict__ lse, long lse_rs,
                                          LAS unsigned char* vimg, int lane,
                                          bf16x8 (&qf)[DH / 16], bf16x8 (&kf)[KT / 32][DH / 16], u32x4 (&vv)[KT * (DH / 8) / 64],
                                          bool has_next, unsigned Qn, unsigned Kn, unsigned Vn, int n0n, int kt_hi_n) {
    constexpr int ND = DH / 16, NH = KT / 32, NB = DH / 32, VP = DH * 2 + 16, CPR = DH / 8, NCH = KT * CPR / 64;
    constexpr bool PFV = true;
    const int r = lane & 31, h = lane >> 5;
    f32x16 o[NB];
#pragma unroll
    for (int db = 0; db < NB; ++db)
#pragma unroll
        for (int i = 0; i < 16; ++i) o[db][i] = 0.f;
    float m_run = -1e30f, l_run = 0.f, R = 1.0f;
    const int qn = n0 + r;
    const LAS unsigned char* vrd = vimg + (4 * h + ((lane & 15) >> 2)) * VP + ((lane >> 4) & 1) * 32 + (lane & 3) * 8;
    bool primed_next = false;
    for (int kt = kt_hi; kt >= kt_lo; --kt) {
        const int key0 = kt * KT;
        if (PFV) { asm volatile("s_waitcnt lgkmcnt(0)" ::: "memory");
#pragma unroll
            for (int i = 0; i < NCH; ++i) { const int c = i * 64 + lane, row = c / CPR, ch = c % CPR; *(LAS u32x4*)(vimg + row * VP + ch * 16) = vv[i]; } }
        f32x16 p[NH];
#pragma unroll
        for (int hf = 0; hf < NH; ++hf) {
#pragma unroll
            for (int i = 0; i < 16; ++i) p[hf][i] = 0.f;
#pragma unroll
            for (int d0 = 0; d0 < ND; ++d0) p[hf] = MFMA32(kf[hf][d0], qf[d0], p[hf]); }
        if (kt > kt_lo) { ATT_LOAD_K(K, kt - 1, kf); ATT_LOAD_V(V, kt - 1, vv); }
        else if (has_next) { ATT_LOAD_Q(Qn, n0n, qf); ATT_LOAD_K(Kn, kt_hi_n, kf); ATT_LOAD_V(Vn, kt_hi_n, vv); primed_next = true; }
        if (MODE == MODE_STICK) {
            float run = R;
#pragma unroll
            for (int hf = NH - 1; hf >= 0; --hf) {
                float beta[16], keep[16];
#pragma unroll
                for (int i = 0; i < 16; ++i) { const float z = __builtin_fmaxf(p[hf][i], -87.0f);
                    const float e = __builtin_amdgcn_exp2f(-1.4426950408889634f * z); const float rr = __builtin_amdgcn_rcpf(1.0f + e);
                    beta[i] = rr; keep[i] = e * rr; }
                if (kt == kt_hi) {
#pragma unroll
                    for (int i = 0; i < 16; ++i) { const int kn = key0 + 32 * hf + crow(i, h); if (kn >= qn) { beta[i] = 0.f; keep[i] = 1.0f; } }
                }
                float G[4], PG[4];
#pragma unroll
                for (int g = 0; g < 4; ++g) { G[g] = (keep[4 * g] * keep[4 * g + 1]) * (keep[4 * g + 2] * keep[4 * g + 3]); PG[g] = xhalf(G[g], h); }
#pragma unroll
                for (int g = 3; g >= 0; --g) {
                    const float c3 = (h == 0) ? run * PG[g] : run;
                    const float c2 = c3 * keep[4 * g + 3], c1 = c2 * keep[4 * g + 2], c0 = c1 * keep[4 * g + 1];
                    p[hf][4 * g + 3] = beta[4 * g + 3] * c3; p[hf][4 * g + 2] = beta[4 * g + 2] * c2; p[hf][4 * g + 1] = beta[4 * g + 1] * c1; p[hf][4 * g] = beta[4 * g] * c0;
                    run = run * (G[g] * PG[g]); }
                __builtin_amdgcn_sched_barrier(0);
            }
            R = run;
        } else {
            const float c2 = (MODE == MODE_XATTN ? sscale : 1.0f) * 1.4426950408889634f;
            float tmax = -1e30f;
            const bool need_mask = (MODE == MODE_BAND) && (kt == kt_hi || key0 < n0 + 31 - 128);
            if (need_mask) { const int dlt = key0 + 4 * h - qn;
#pragma unroll
                for (int hf = 0; hf < NH; ++hf)
#pragma unroll
                    for (int i = 0; i < 16; ++i) { const int dd = dlt + 32 * hf + (i & 3) + 8 * (i >> 2); float s = p[hf][i] * c2; if ((unsigned)(dd + 128) > 128u) s = -1e30f; p[hf][i] = s; tmax = __builtin_fmaxf(tmax, s); }
            } else {
#pragma unroll
                for (int hf = 0; hf < NH; ++hf)
#pragma unroll
                    for (int i = 0; i < 16; ++i) { const float s = p[hf][i] * c2; p[hf][i] = s; tmax = __builtin_fmaxf(tmax, s); }
            }
            tmax = xmax(tmax);
            const float m_new = __builtin_fmaxf(m_run, tmax);
            const float alpha = __builtin_amdgcn_exp2f(m_run - m_new);
            m_run = m_new; l_run *= alpha;
            float ls = 0.f;
#pragma unroll
            for (int hf = 0; hf < NH; ++hf)
#pragma unroll
                for (int i = 0; i < 16; ++i) { const float e = __builtin_amdgcn_exp2f(p[hf][i] - m_new); p[hf][i] = e; ls += e; }
            l_run += ls;
#pragma unroll
            for (int db = 0; db < NB; ++db)
#pragma unroll
                for (int i = 0; i < 16; ++i) o[db][i] *= alpha;
        }
        if (!PFV) { asm volatile("s_waitcnt lgkmcnt(0)" ::: "memory");
#pragma unroll
            for (int i = 0; i < NCH; ++i) { const int c = i * 64 + lane, row = c / CPR, ch = c % CPR; *(LAS u32x4*)(vimg + row * VP + ch * 16) = vv[i]; } }
        asm volatile("s_waitcnt lgkmcnt(0)" ::: "memory");
#pragma unroll
        for (int s = 0; s < KT / 16; ++s) { const int hf = s >> 1, sb = (s & 1) * 8;
            u32x4 pw; pw.x = cvtpk(p[hf][sb], p[hf][sb + 1]); pw.y = cvtpk(p[hf][sb + 2], p[hf][sb + 3]); pw.z = cvtpk(p[hf][sb + 4], p[hf][sb + 5]); pw.w = cvtpk(p[hf][sb + 6], p[hf][sb + 7]);
            const bf16x8 pf = __builtin_bit_cast(bf16x8, pw);
#pragma unroll
            for (int db = 0; db < NB; ++db) { const s16x4 lo = vtr(vrd + (16 * s) * VP + db * 64), hi = vtr(vrd + (16 * s + 8) * VP + db * 64);
                const bf16x8 vf = __builtin_shufflevector(lo, hi, 0, 1, 2, 3, 4, 5, 6, 7);
                o[db] = MFMA32(vf, pf, o[db]); } }
        if (MODE == MODE_STICK) { if (__all(R == 0.0f)) break; }
    }
    float inv = 1.0f;
    if (MODE != MODE_STICK) { const float lt = xsum(l_run); inv = 1.0f / lt;
        if (MODE == MODE_BAND) { if (h == 0) lse[(long)qn * lse_rs] = (m_run + __builtin_log2f(lt)) * 0.6931471805599453f; } }
    bf16_t* orow = O + (long)qn * o_rs + 4 * h;
#pragma unroll
    for (int db = 0; db < NB; ++db)
#pragma unroll
        for (int g = 0; g < 4; ++g) { u32x2 w; w.x = cvtpk(o[db][4 * g] * inv, o[db][4 * g + 1] * inv); w.y = cvtpk(o[db][4 * g + 2] * inv, o[db][4 * g + 3] * inv);
            *(u32x2*)(orow + 32 * db + 8 * g) = w; }
    if (has_next && !primed_next) { ATT_LOAD_Q(Qn, n0n, qf); ATT_LOAD_K(Kn, kt_hi_n, kf); ATT_LOAD_V(Vn, kt_hi_n, vv); }
}

constexpr int XP = 272;
__device__ __forceinline__ void xattn_fill(const bf16_t* __restrict__ Kg, const bf16_t* __restrict__ Vg, LAS unsigned char* kimg, LAS unsigned char* vimg_all, int tid_) {
#pragma unroll
    for (int i = 0; i < 8; ++i) { const int c = i * 512 + tid_, row = c >> 4, ch = c & 15;
        const u32x4 kv = *(const u32x4*)(Kg + (long)row * 1024 + ch * 8), vv = *(const u32x4*)(Vg + (long)row * 1024 + ch * 8);
        *(LAS u32x4*)(kimg + row * XP + ch * 16) = kv; *(LAS u32x4*)(vimg_all + row * XP + ch * 16) = vv; }
}
__device__ __forceinline__ void xattn_q_load(const bf16_t* __restrict__ Q, int n0, bf16x8 (&qf)[8], int lane) {
    const int r = lane & 31, h = lane >> 5;
#pragma unroll
    for (int d0 = 0; d0 < 8; ++d0) qf[d0] = *(const bf16x8*)(Q + (long)(n0 + r) * 128 + 16 * d0 + 8 * h);
}
__device__ __forceinline__ void xattn_item_lds(const bf16x8 (&qf)[8], int n0, float sscale, bf16_t* __restrict__ O, long o_rs, const LAS unsigned char* kimg, const LAS unsigned char* vimg_all, int lane) {
    constexpr int DH = 128, ND = 8, NB = 4;
    const int r = lane & 31, h = lane >> 5;
    f32x16 o[NB];
#pragma unroll
    for (int db = 0; db < NB; ++db)
#pragma unroll
        for (int i = 0; i < 16; ++i) o[db][i] = 0.f;
    float m_run = -1e30f, l_run = 0.f;
    const LAS unsigned char* krd = kimg + r * XP + 16 * h;
    const LAS unsigned char* vrd = vimg_all + (4 * h + ((lane & 15) >> 2)) * XP + ((lane >> 4) & 1) * 32 + (lane & 3) * 8;
    const float c2 = sscale * 1.4426950408889634f;
    for (int kt = 0; kt < 8; ++kt) {
        f32x16 p;
#pragma unroll
        for (int i = 0; i < 16; ++i) p[i] = 0.f;
#pragma unroll
        for (int d0 = 0; d0 < ND; ++d0) { const bf16x8 kf = *(const LAS bf16x8*)(krd + kt * 32 * XP + d0 * 32); p = MFMA32(kf, qf[d0], p); }
        float tmax = -1e30f;
#pragma unroll
        for (int i = 0; i < 16; ++i) { p[i] *= c2; tmax = __builtin_fmaxf(tmax, p[i]); }
        tmax = xmax(tmax);
        if (__any(tmax > m_run + 8.0f)) { const float m_new = __builtin_fmaxf(m_run, tmax), alpha = __builtin_amdgcn_exp2f(m_run - m_new); m_run = m_new; l_run *= alpha;
#pragma unroll
            for (int db = 0; db < NB; ++db)
#pragma unroll
                for (int i = 0; i < 16; ++i) o[db][i] *= alpha; }
        float ls = 0.f;
#pragma unroll
        for (int i = 0; i < 16; ++i) { const float e = __builtin_amdgcn_exp2f(p[i] - m_run); p[i] = e; ls += e; }
        l_run += ls;
#pragma unroll
        for (int s = 0; s < 2; ++s) { const int sb = s * 8;
            u32x4 pw; pw.x = cvtpk(p[sb], p[sb + 1]); pw.y = cvtpk(p[sb + 2], p[sb + 3]); pw.z = cvtpk(p[sb + 4], p[sb + 5]); pw.w = cvtpk(p[sb + 6], p[sb + 7]);
            const bf16x8 pf = __builtin_bit_cast(bf16x8, pw);
#pragma unroll
            for (int db = 0; db < NB; ++db) { const s16x4 lo = vtr(vrd + (kt * 32 + 16 * s) * XP + db * 64), hi = vtr(vrd + (kt * 32 + 16 * s + 8) * XP + db * 64);
                const bf16x8 vf = __builtin_shufflevector(lo, hi, 0, 1, 2, 3, 4, 5, 6, 7);
                o[db] = MFMA32(vf, pf, o[db]); } }
    }
    const float inv = 1.0f / xsum(l_run);
    bf16_t* orow = O + (long)(n0 + r) * o_rs;
#pragma unroll
    for (int db = 0; db < NB; ++db) store_o32(orow + 32 * db, o[db], inv, h);
}

constexpr int BP = 144;
__device__ __forceinline__ void band_fill(const bf16_t* __restrict__ base, unsigned Ko, unsigned Vo, int kr0, int nrows, LAS unsigned char* kimg, LAS unsigned char* vimg2, int tid_) {
    for (int c = tid_; c < nrows * 8; c += 512) { const int row = c >> 3, ch = c & 7; const unsigned eo = (unsigned)((kr0 + row) * 64 + ch * 8);
        const u32x4 kv = *(const u32x4*)((const char*)base + 2u * (Ko + eo)), vv = *(const u32x4*)((const char*)base + 2u * (Vo + eo));
        *(LAS u32x4*)(kimg + row * BP + ch * 16) = kv; *(LAS u32x4*)(vimg2 + row * BP + ch * 16) = vv; }
}

__device__ __forceinline__ void img_load(const bf16_t* __restrict__ base, unsigned Ko, unsigned Vo, int kr0, int nrows, u32x4 (&kreg)[8], u32x4 (&vreg)[8], int tid_) {
#pragma unroll
    for (int i = 0; i < 8; ++i) { const int c = i * 512 + tid_; if (c < nrows * 8) { const int row = c >> 3, ch = c & 7; const unsigned eo = (unsigned)((kr0 + row) * 64 + ch * 8);
        kreg[i] = *(const u32x4*)((const char*)base + 2u * (Ko + eo)); vreg[i] = *(const u32x4*)((const char*)base + 2u * (Vo + eo)); } }
}
__device__ __forceinline__ void img_store(LAS unsigned char* kimg, LAS unsigned char* vimg2, int nrows, const u32x4 (&kreg)[8], const u32x4 (&vreg)[8], int tid_) {
#pragma unroll
    for (int i = 0; i < 8; ++i) { const int c = i * 512 + tid_; if (c < nrows * 8) { const int row = c >> 3, ch = c & 7;
        *(LAS u32x4*)(kimg + row * BP + ch * 16) = kreg[i]; *(LAS u32x4*)(vimg2 + row * BP + ch * 16) = vreg[i]; } }
}
__device__ __forceinline__ void band_item_lds(const bf16_t* __restrict__ base, unsigned Qo, int qrow, int n0, int row0, int kn0, int ntiles, bf16_t* __restrict__ O, long o_rs, float* __restrict__ lse, long lse_rs,
                                              const LAS unsigned char* kimg, const LAS unsigned char* vimg2, int lane) {
    const int r = lane & 31, h = lane >> 5;
    bf16x8 qf[4];
#pragma unroll
    for (int d0 = 0; d0 < 4; ++d0) qf[d0] = *(const bf16x8*)((const char*)base + 2u * (Qo + (unsigned)((qrow + r) * 64 + 16 * d0 + 8 * h)));
    f32x16 o[2];
#pragma unroll
    for (int db = 0; db < 2; ++db)
#pragma unroll
        for (int i = 0; i < 16; ++i) o[db][i] = 0.f;
    float m_run = -1e30f, l_run = 0.f;
    const int qn = n0 + r; const unsigned lo = (unsigned)(qn < 128 ? qn : 128);
    const LAS unsigned char* krd = kimg + (row0 + r) * BP + 16 * h;
    const LAS unsigned char* vrd = vimg2 + (row0 + 4 * h + ((lane & 15) >> 2)) * BP + ((lane >> 4) & 1) * 32 + (lane & 3) * 8;
    for (int j = ntiles - 1; j >= 0; --j) {
        const int key0 = kn0 + 32 * j;
        if (key0 + 31 < 0) break;
        f32x16 p;
#pragma unroll
        for (int i = 0; i < 16; ++i) p[i] = 0.f;
#pragma unroll
        for (int d0 = 0; d0 < 4; ++d0) { const bf16x8 kf = *(const LAS bf16x8*)(krd + j * 32 * BP + d0 * 32); p = MFMA32(kf, qf[d0], p); }
        float tmax = -1e30f;
        const bool need_mask = (j == ntiles - 1) || (key0 < n0 + 31 - 128) || (key0 < 0);
        if (need_mask) { const int dlt = key0 + 4 * h - qn;
#pragma unroll
            for (int i = 0; i < 16; ++i) { const int dd = dlt + (i & 3) + 8 * (i >> 2); float sv = p[i] * 1.4426950408889634f; if ((unsigned)(dd + (int)lo) > lo) sv = -1e30f; p[i] = sv; tmax = __builtin_fmaxf(tmax, sv); }
        } else {
#pragma unroll
            for (int i = 0; i < 16; ++i) { const float sv = p[i] * 1.4426950408889634f; p[i] = sv; tmax = __builtin_fmaxf(tmax, sv); }
        }
        tmax = xmax(tmax);
        if (__any(tmax > m_run + 8.0f)) { const float m_new = __builtin_fmaxf(m_run, tmax), alpha = __builtin_amdgcn_exp2f(m_run - m_new); m_run = m_new; l_run *= alpha;
#pragma unroll
            for (int db = 0; db < 2; ++db)
#pragma unroll
                for (int i = 0; i < 16; ++i) o[db][i] *= alpha; }
        float ls = 0.f;
#pragma unroll
        for (int i = 0; i < 16; ++i) { const float e = __builtin_amdgcn_exp2f(p[i] - m_run); p[i] = e; ls += e; }
        l_run += ls;
#pragma unroll
        for (int s = 0; s < 2; ++s) { const int sb = s * 8;
            u32x4 pw; pw.x = cvtpk(p[sb], p[sb + 1]); pw.y = cvtpk(p[sb + 2], p[sb + 3]); pw.z = cvtpk(p[sb + 4], p[sb + 5]); pw.w = cvtpk(p[sb + 6], p[sb + 7]);
            const bf16x8 pf = __builtin_bit_cast(bf16x8, pw);
#pragma unroll
            for (int db = 0; db < 2; ++db) { const s16x4 lo4 = vtr(vrd + (j * 32 + 16 * s) * BP + db * 64), hi4 = vtr(vrd + (j * 32 + 16 * s + 8) * BP + db * 64);
                const bf16x8 vf = __builtin_shufflevector(lo4, hi4, 0, 1, 2, 3, 4, 5, 6, 7);
                o[db] = MFMA32(vf, pf, o[db]); } }
    }
    const float lt = xsum(l_run), inv = 1.0f / lt;
    if (h == 0) lse[(long)qn * lse_rs] = (m_run + __builtin_log2f(lt)) * 0.6931471805599453f;
    bf16_t* orow = O + (long)qn * o_rs;
#pragma unroll
    for (int db = 0; db < 2; ++db) store_o32(orow + 32 * db, o[db], inv, h);
}

__device__ __forceinline__ bool stick_round_lds(const bf16x8 (&qf)[4], f32x16 (&o)[2], float& R, int n0, int kb_hi, int base_row, const LAS unsigned char* kimg, const LAS unsigned char* vimg2, int lane) {
    const int r = lane & 31, h = lane >> 5, qn = n0 + r;
    const LAS unsigned char* krd = kimg + r * BP + 16 * h;
    const LAS unsigned char* vrd = vimg2 + (4 * h + ((lane & 15) >> 2)) * BP + ((lane >> 4) & 1) * 32 + (lane & 3) * 8;
    for (int kb = kb_hi; kb >= base_row; kb -= 32) {
        const int ro = kb - base_row;
        f32x16 p;
#pragma unroll
        for (int i = 0; i < 16; ++i) p[i] = 0.f;
#pragma unroll
        for (int d0 = 0; d0 < 4; ++d0) { const bf16x8 kf = *(const LAS bf16x8*)(krd + ro * BP + d0 * 32); p = MFMA32(kf, qf[d0], p); }
        float beta[16], keep[16];
#pragma unroll
        for (int i = 0; i < 16; ++i) { const float z = __builtin_fmaxf(p[i], -87.0f); const float e = __builtin_amdgcn_exp2f(-1.4426950408889634f * z); const float rr = __builtin_amdgcn_rcpf(1.0f + e); beta[i] = rr; keep[i] = e * rr; }
        if (kb == n0) {
#pragma unroll
            for (int i = 0; i < 16; ++i) { const int kn = kb + crow(i, h); if (kn >= qn) { beta[i] = 0.f; keep[i] = 1.0f; } }
        }
        float G[4], PG[4];
#pragma unroll
        for (int g = 0; g < 4; ++g) { G[g] = (keep[4 * g] * keep[4 * g + 1]) * (keep[4 * g + 2] * keep[4 * g + 3]); PG[g] = xhalf(G[g], h); }
        float run = R;
#pragma unroll
        for (int g = 3; g >= 0; --g) {
            const float c3 = (h == 0) ? run * PG[g] : run;
            const float c2 = c3 * keep[4 * g + 3], c1 = c2 * keep[4 * g + 2], c0 = c1 * keep[4 * g + 1];
            p[4 * g + 3] = beta[4 * g + 3] * c3; p[4 * g + 2] = beta[4 * g + 2] * c2; p[4 * g + 1] = beta[4 * g + 1] * c1; p[4 * g] = beta[4 * g] * c0;
            run = run * (G[g] * PG[g]); }
        R = run;
#pragma unroll
        for (int s = 0; s < 2; ++s) { const int sb = s * 8;
            u32x4 pw; pw.x = cvtpk(p[sb], p[sb + 1]); pw.y = cvtpk(p[sb + 2], p[sb + 3]); pw.z = cvtpk(p[sb + 4], p[sb + 5]); pw.w = cvtpk(p[sb + 6], p[sb + 7]);
            const bf16x8 pf = __builtin_bit_cast(bf16x8, pw);
#pragma unroll
            for (int db = 0; db < 2; ++db) { const s16x4 lo4 = vtr(vrd + (ro + 16 * s) * BP + db * 64), hi4 = vtr(vrd + (ro + 16 * s + 8) * BP + db * 64);
                const bf16x8 vf = __builtin_shufflevector(lo4, hi4, 0, 1, 2, 3, 4, 5, 6, 7);
                o[db] = MFMA32(vf, pf, o[db]); } }
        if (__all(R == 0.0f)) return true;
    }
    return false;
}
#undef ATT_LOAD_K
#undef ATT_LOAD_V
#undef ATT_LOAD_Q
#undef LAS
}
#define LAS __attribute__((address_space(3)))
typedef unsigned short bf16;
typedef unsigned v4u __attribute__((ext_vector_type(4)));
typedef unsigned v2u __attribute__((ext_vector_type(2)));
typedef float f32x4 __attribute__((ext_vector_type(4)));
constexpr int NWAVES = 8, NTHREADS = 512;
constexpr int T = 65536, D = 1024, SEQ = 2048, NB_ = 32, DIN = 4352, DFF = 2816, MEMT = 8192;
constexpr float EPS = 1e-6f;
constexpr int XNP = 1280, OP = 1280;
constexpr size_t MiB = 1u << 20;
constexpr size_t OFF_WIN = 0;
constexpr size_t OFF_WGATE = OFF_WIN + 4352ull * 1024 * 2;
constexpr size_t OFF_WSB = OFF_WGATE + 3072ull * 1024 * 2;
constexpr size_t OFF_WDIL = OFF_WSB + 1024ull * 512 * 2;
constexpr size_t OFF_WMEM = OFF_WDIL + 1024ull * 256 * 2;
constexpr size_t OFF_WO = OFF_WMEM + 1024ull * 512 * 2;
constexpr size_t OFF_WFI = OFF_WO + 1024ull * 1024 * 2;
constexpr size_t OFF_WFO = OFF_WFI + 5632ull * 1024 * 2;
constexpr size_t OFF_WKV = OFF_WFO + 1024ull * 2816 * 2;
constexpr size_t OFF_ROPE = OFF_WKV + 1024ull * 1024 * 2;
constexpr size_t OFF_MEMN = OFF_ROPE + 2048ull * 64 * 4;
constexpr size_t OFF_KVM = OFF_MEMN + 8192ull * 1024 * 2;
constexpr size_t OFF_R1 = 72 * MiB;
constexpr size_t OFF_R2 = OFF_R1 + 544 * MiB;
constexpr size_t WS_END = OFF_R2 + 352 * MiB;
static_assert(OFF_KVM + 8192ull * 1024 * 2 <= OFF_R1, "ws map");
constexpr size_t OFF_PROJ = OFF_R1, OFF_GS = OFF_R1, OFF_MERGED = OFF_R1 + 128 * MiB, OFF_XN2 = OFF_R1 + 256 * MiB, OFF_FO = OFF_R1 + 384 * MiB;
constexpr size_t OFF_OBG = OFF_R2, OFF_LSE = OFF_R2 + 96 * MiB, OFF_OA = OFF_R2 + 100 * MiB, OFF_OB = OFF_R2 + 164 * MiB, OFF_OC = OFF_R2 + 196 * MiB, OFF_MIX = OFF_R1, OFF_F = OFF_R2;
constexpr int LDS_BYTES = 147456;

__device__ __forceinline__ unsigned f2bf(float f) { unsigned u = __builtin_bit_cast(unsigned, f); return (u + 0x7fffu + ((u >> 16) & 1u)) >> 16; }
__device__ __forceinline__ unsigned pk2(float lo, float hi) { return f2bf(lo) | (f2bf(hi) << 16); }
__device__ __forceinline__ float wave_sum(float v) {
#pragma unroll
    for (int o = 1; o < 64; o <<= 1) v += __shfl_xor(v, o);
    return v;
}
template <int MAP> __device__ __forceinline__ int map_row(int n) {
    if (MAP == 1) { if (n >= 1536 && n < 3840 && (((n - 1536) >> 8) % 3) != 2) return (n & ~63) + 2 * (n & 31) + ((n >> 5) & 1); return n; }
    if (MAP == 2) { const int f = n < DFF ? n : n - DFF; return (f >> 7) * 256 + (n < DFF ? 0 : 128) + (f & 127); }
    return n;
}
template <int MAP> __device__ __forceinline__ void transpose_item(const float* __restrict__ W, int K, int N, bf16* __restrict__ WT, int ldw, int coff, LAS float* scr, int item, int lane_) {
    const int nblk = N / 32, kb = item / nblk, nb = item % nblk, k0 = 64 * kb, n0 = 32 * nb;
#pragma unroll 8
    for (int i = 0; i < 32; ++i) { const int kk = 2 * i + (lane_ >> 5); scr[kk * 33 + (lane_ & 31)] = W[(size_t)(k0 + kk) * N + n0 + (lane_ & 31)]; }
    asm volatile("s_waitcnt lgkmcnt(0)" ::: "memory");
    const int c = lane_ & 7;
#pragma unroll
    for (int j = 0; j < 4; ++j) { const int n = (lane_ >> 3) + 8 * j; const LAS float* s = scr + (8 * c) * 33 + n;
        v4u o; o.x = pk2(s[0 * 33], s[1 * 33]); o.y = pk2(s[2 * 33], s[3 * 33]); o.z = pk2(s[4 * 33], s[5 * 33]); o.w = pk2(s[6 * 33], s[7 * 33]);
        const int nn = n0 + n; const size_t dst = (MAP == 3) ? (size_t)(nn & 1023) * ldw + (nn >> 10) * 1024 : (size_t)map_row<MAP>(nn) * ldw + coff;
        *(v4u*)(WT + dst + k0 + 8 * c) = o; }
    asm volatile("s_waitcnt lgkmcnt(0)" ::: "memory");
}
__device__ __forceinline__ void rms_row_to_bf16(const float* __restrict__ xrow, const float* __restrict__ g, bf16* __restrict__ orow, int lane) {
    const f32x4* xr = (const f32x4*)xrow + lane; const f32x4* gr = (const f32x4*)g + lane;
    f32x4 v[4]; float s = 0.f;
#pragma unroll
    for (int j = 0; j < 4; ++j) { v[j] = xr[64 * j]; s += (v[j].x * v[j].x + v[j].y * v[j].y) + (v[j].z * v[j].z + v[j].w * v[j].w); }
    const float rstd = 1.0f / sqrtf(wave_sum(s) * (1.0f / D) + EPS);
    unsigned long long* o8 = (unsigned long long*)orow + lane;
#pragma unroll
    for (int j = 0; j < 4; ++j) { const f32x4 gg = gr[64 * j];
        o8[64 * j] = (unsigned long long)pk2(v[j].x * rstd * gg.x, v[j].y * rstd * gg.y) | ((unsigned long long)pk2(v[j].z * rstd * gg.z, v[j].w * rstd * gg.w) << 32); }
}
__device__ __forceinline__ void rms_row2_to_bf16(const float* __restrict__ xa, const float* __restrict__ xb, const float* __restrict__ g, bf16* __restrict__ oa, bf16* __restrict__ ob, int lane_) {
    const f32x4* ra = (const f32x4*)xa + lane_; const f32x4* rb = (const f32x4*)xb + lane_; const f32x4* gr = (const f32x4*)g + lane_;
    f32x4 va[4], vb[4]; float sa = 0.f, sb = 0.f;
#pragma unroll
    for (int j = 0; j < 4; ++j) { va[j] = ra[64 * j]; vb[j] = rb[64 * j]; }
#pragma unroll
    for (int j = 0; j < 4; ++j) { sa += (va[j].x * va[j].x + va[j].y * va[j].y) + (va[j].z * va[j].z + va[j].w * va[j].w); sb += (vb[j].x * vb[j].x + vb[j].y * vb[j].y) + (vb[j].z * vb[j].z + vb[j].w * vb[j].w); }
    const float rsa = 1.0f / sqrtf(wave_sum(sa) * (1.0f / D) + EPS), rsb = 1.0f / sqrtf(wave_sum(sb) * (1.0f / D) + EPS);
    unsigned long long* pa = (unsigned long long*)oa + lane_; unsigned long long* pb = (unsigned long long*)ob + lane_;
#pragma unroll
    for (int j = 0; j < 4; ++j) { const f32x4 gg = gr[64 * j];
        pa[64 * j] = (unsigned long long)pk2(va[j].x * rsa * gg.x, va[j].y * rsa * gg.y) | ((unsigned long long)pk2(va[j].z * rsa * gg.z, va[j].w * rsa * gg.w) << 32);
        pb[64 * j] = (unsigned long long)pk2(vb[j].x * rsb * gg.x, vb[j].y * rsb * gg.y) | ((unsigned long long)pk2(vb[j].z * rsb * gg.z, vb[j].w * rsb * gg.w) << 32); }
}
__device__ __forceinline__ float bfl(unsigned w) { return __uint_as_float(w << 16); }
__device__ __forceinline__ float bfh(unsigned w) { return __uint_as_float(w & 0xffff0000u); }

#define XB_TMO      128
#define XB_XCNT(j)  (256  + 64 * (j))
#define XB_XSUB(j)  (1280 + 64 * (j))
#define XB_XGEN(j)  (2304 + 64 * (j))
#define XB_TOP      3328
#define XB_TOPGEN   3392
#define XCD_BAR_WORDS 3456
#define XB_SPIN_CAP (1u << 18)

__device__ __forceinline__ unsigned xb_ld(unsigned* p)              { return __hip_atomic_load(p, __ATOMIC_RELAXED, __HIP_MEMORY_SCOPE_AGENT); }
__device__ __forceinline__ unsigned xb_add(unsigned* p, unsigned v) { return __hip_atomic_fetch_add(p, v, __ATOMIC_RELAXED, __HIP_MEMORY_SCOPE_AGENT); }
__device__ __forceinline__ unsigned xb_xcc_id() { return (unsigned)__builtin_amdgcn_s_getreg((3 << 11) | 20) & 0xFu; }
#define XB_SPIN(cond, bar) do { unsigned _sp = 0; while (cond) { __builtin_amdgcn_s_sleep(1); \
    if ((++_sp & 255u) == 0u) { if (xb_ld(&(bar)[XB_TMO])) break; if (_sp > XB_SPIN_CAP) { atomicAdd(&(bar)[XB_TMO], 1u); break; } } } } while (0)

struct XcdBarrier {
    unsigned* bar; unsigned x;
    volatile LAS unsigned* st;
};

__device__ __forceinline__ XcdBarrier xcd_barrier_post(unsigned* bar, volatile LAS unsigned* st) {
    XcdBarrier b; b.bar = bar; b.x = xb_xcc_id(); b.st = st;
    if (threadIdx.x == 0) (void)xb_add(&bar[XB_XCNT(b.x)], 1u);
    return b;
}
__device__ __forceinline__ void xcd_barrier_complete(unsigned* bar, unsigned x, unsigned& nloc, unsigned& nx) {
    const unsigned G = gridDim.x * gridDim.y * gridDim.z;
    unsigned sum, cnt, mine, sp = 0u;
    for (;;) {
        sum = 0u; cnt = 0u; mine = 0u;
#pragma unroll
        for (unsigned j = 0; j < 16; ++j) { const unsigned c = xb_ld(&bar[XB_XCNT(j)]); sum += c; cnt += (c > 0u) ? 1u : 0u; mine = (j == x) ? c : mine; }
        if (sum == G) break;
        __builtin_amdgcn_s_sleep(1);
        if ((++sp & 255u) == 0u) { if (xb_ld(&bar[XB_TMO])) break; if (sp > XB_SPIN_CAP) { atomicAdd(&bar[XB_TMO], 1u); break; } }
    }
    nloc = mine > 0u ? mine : 1u; nx = cnt > 0u ? cnt : 1u;
}

__device__ __forceinline__ void xcd_barrier(const XcdBarrier& b) {
    asm volatile("s_waitcnt vmcnt(0)" ::: "memory");
    __syncthreads();
    if (threadIdx.x == 0) {
        unsigned* bar = b.bar;
        __builtin_amdgcn_s_waitcnt(0);
        unsigned nloc = b.st[0], nx = b.st[1];
        if (nloc == 0u) { xcd_barrier_complete(bar, b.x, nloc, nx); b.st[0] = nloc; b.st[1] = nx; }
        const unsigned old = xb_add(&bar[XB_XSUB(b.x)], 1u);
        const unsigned gen = old / nloc;
        if (old + 1u == (gen + 1u) * nloc) {
            __builtin_amdgcn_fence(__ATOMIC_RELEASE, "agent");
            asm volatile("s_waitcnt vmcnt(0)" ::: "memory");
            const unsigned og = xb_add(&bar[XB_TOP], 1u);
            const unsigned tg = og / nx;
            if (og + 1u == (tg + 1u) * nx) xb_add(&bar[XB_TOPGEN], 1u);
            else XB_SPIN(xb_ld(&bar[XB_TOPGEN]) == tg, bar);
            __builtin_amdgcn_fence(__ATOMIC_ACQUIRE, "agent");
            xb_add(&bar[XB_XGEN(b.x)], 1u);
            asm volatile("s_waitcnt vmcnt(0)" ::: "memory");
        } else {
            XB_SPIN(xb_ld(&bar[XB_XGEN(b.x)]) == gen, bar);
            __builtin_amdgcn_fence(__ATOMIC_ACQUIRE, "agent");
            asm volatile("s_waitcnt vmcnt(0)" ::: "memory");
        }
    }
    __syncthreads();
}

constexpr size_t OFF_BAR = 970 * MiB;
constexpr int MISC_OFF = 147456 - 16 - 32;
struct Args { const float* in[17]; float* out; unsigned char* ws; };

__global__ void __launch_bounds__(NTHREADS) fwd_megakernel(Args a) {
    extern __shared__ __attribute__((aligned(16))) unsigned char lds_raw[];
    cg::grid_group grid = cg::this_grid();
    LAS unsigned char* lds = (LAS unsigned char*)lds_raw;
#define tid ((int)threadIdx.x)
#define lane ((int)threadIdx.x & 63)
#define wave (__builtin_amdgcn_readfirstlane((int)threadIdx.x >> 6))
#define G ((int)gridDim.x)
#define bx ((int)blockIdx.x)
#define gw (bx * NWAVES + wave)
#define NGW (G * NWAVES)
#define xin (a.in[0])
#define mem (a.in[1])
#define g_pre_mix (a.in[2])
#define g_post_mix (a.in[3])
#define g_pre_ffn (a.in[4])
#define g_post_ffn (a.in[5])
#define g_mem (a.in[6])
#define w_in (a.in[7])
#define w_mem_kv (a.in[8])
#define w_br_sb (a.in[9])
#define w_br_dil (a.in[10])
#define w_br_mem (a.in[11])
#define w_gate (a.in[12])
#define b_gate (a.in[13])
#define w_o (a.in[14])
#define w_ffn_in (a.in[15])
#define w_ffn_out (a.in[16])
#define XN ((bf16*)a.out)
#define WIN ((bf16*)(a.ws + OFF_WIN))
#define WCAT ((bf16*)(a.ws + OFF_WGATE))
#define WSB ((bf16*)(a.ws + OFF_WSB))
#define WDIL ((bf16*)(a.ws + OFF_WDIL))
#define WMEM ((bf16*)(a.ws + OFF_WMEM))
#define WO ((bf16*)(a.ws + OFF_WO))
#define WFI ((bf16*)(a.ws + OFF_WFI))
#define WFO ((bf16*)(a.ws + OFF_WFO))
#define WKV ((bf16*)(a.ws + OFF_WKV))
#define MEMN ((bf16*)(a.ws + OFF_MEMN))
#define KVM ((bf16*)(a.ws + OFF_KVM))
#define ROPE ((float*)(a.ws + OFF_ROPE))
#define PROJ ((bf16*)(a.ws + OFF_PROJ))
#define GS ((bf16*)(a.ws + OFF_GS))
#define MERGED ((bf16*)(a.ws + OFF_MERGED))
#define XN2 ((bf16*)(a.ws + OFF_XN2))
#define FO ((bf16*)(a.ws + OFF_FO))
#define OBG ((bf16*)(a.ws + OFF_OBG))
#define OA ((bf16*)(a.ws + OFF_OA))
#define OB (OA + 512)
#define OC (OA + 768)
#define MIX ((bf16*)(a.ws + OFF_MIX))
#define FB ((bf16*)(a.ws + OFF_F))
#define LSE ((float*)(a.ws + OFF_LSE))
    volatile LAS unsigned* MISC = (volatile LAS unsigned*)(lds + MISC_OFF);
    if (tid < 2) MISC[8 + tid] = 0u;
    unsigned* barw = (unsigned*)(a.ws + OFF_BAR);
    if (bx == 0) for (int i = tid; i < XCD_BAR_WORDS; i += NTHREADS) barw[i] = 0u;
    __syncthreads();

    {
        LAS float* scr = (LAS float*)(lds + wave * 16384);
        constexpr int I_IN = 16 * (DIN / 32), I_G = 16 * (3072 / 32), I_SB = 8 * 32, I_DIL = 4 * 32, I_MEM = 8 * 32, I_O = 16 * 32, I_FI = 16 * (5632 / 32), I_FO = 44 * 32, I_KV = 16 * 32;
        constexpr int NITEMS = I_IN + I_G + I_SB + I_DIL + I_MEM + I_O + I_FI + I_FO + I_KV;
        for (int it = gw; it < NITEMS; it += NGW) {
            int r = it;
            if (r < I_IN) { transpose_item<1>(w_in, 1024, DIN, WIN, 1024, 0, scr, r, lane); continue; } r -= I_IN;
            if (r < I_G) { transpose_item<3>(w_gate, 1024, 3072, WCAT, 4352, 0, scr, r, lane); continue; } r -= I_G;
            if (r < I_SB) { transpose_item<0>(w_br_sb, 512, 1024, WCAT, 4352, 3072, scr, r, lane); continue; } r -= I_SB;
            if (r < I_DIL) { transpose_item<0>(w_br_dil, 256, 1024, WCAT, 4352, 3584, scr, r, lane); continue; } r -= I_DIL;
            if (r < I_MEM) { transpose_item<0>(w_br_mem, 512, 1024, WCAT, 4352, 3840, scr, r, lane); continue; } r -= I_MEM;
            if (r < I_O) { transpose_item<0>(w_o, 1024, 1024, WO, 1024, 0, scr, r, lane); continue; } r -= I_O;
            if (r < I_FI) { transpose_item<2>(w_ffn_in, 1024, 5632, WFI, 1024, 0, scr, r, lane); continue; } r -= I_FI;
            if (r < I_FO) { transpose_item<0>(w_ffn_out, DFF, 1024, WFO, DFF, 0, scr, r, lane); continue; } r -= I_FO;
            transpose_item<0>(w_mem_kv, 1024, 1024, WKV, 1024, 0, scr, r, lane);
        }
        for (int m = gw; m < T; m += 2 * NGW) { const int mb = (m + NGW < T) ? m + NGW : m; rms_row2_to_bf16(xin + (size_t)m * D, xin + (size_t)mb * D, g_pre_mix, XN + (size_t)m * XNP, XN + (size_t)mb * XNP, lane); }
        for (int m = gw; m < MEMT; m += 2 * NGW) { const int mb = (m + NGW < MEMT) ? m + NGW : m; rms_row2_to_bf16(mem + (size_t)m * D, mem + (size_t)mb * D, g_mem, MEMN + (size_t)m * D, MEMN + (size_t)mb * D, lane); }
        for (int i = bx * NTHREADS + tid; i < SEQ * 32; i += G * NTHREADS) { const int pos = i >> 5, j = i & 31;
            const float inv_freq = exp2f(-(float)j * (13.287712379549449f / 32.0f));
            const float ang = (float)pos * inv_freq;
            double t = (double)ang * 0.15915494309189535; t -= rint(t);
            const float tf = (float)t;
            ROPE[2 * i] = __builtin_amdgcn_cosf(tf); ROPE[2 * i + 1] = __builtin_amdgcn_sinf(tf); }
    }
    grid.sync();
    (void)xcd_barrier_post(barw, MISC + 8);
#define GRID_BAR() do { XcdBarrier xb_; xb_.bar = (unsigned*)(a.ws + OFF_BAR); xb_.x = xb_xcc_id(); xb_.st = (volatile LAS unsigned*)(lds + MISC_OFF) + 8; xcd_barrier(xb_); } while (0)

    {
        pg8::Gemm g{XN, WIN, T, DIN, D, XNP, D}; pg8::StaticOrder S; S.init(T, DIN, G, bx);
        pg8::EpiProj E{PROJ, ROPE};
        pg8::gemm_phase<pg8::EpiProj, pg8::StaticOrder, true, true>(lds, g, S, E);
    }
    {
        pg8::Gemm g{MEMN, WKV, MEMT, 1024, D}; pg8::StaticOrder S; S.init(MEMT, 1024, G, bx);
        pg8::EpiPlain E{KVM, 1024};
        pg8::gemm_phase<pg8::EpiPlain, pg8::StaticOrder, true, true>(lds, g, S, E);
    }
    GRID_BAR();

    LAS unsigned char* vimg = lds + wave * 16384;
    {
        for (int c = bx; c < NB_ * 8; c += G) {
            const int b = c >> 3, hh = (c >> 1) & 3, h2 = c & 1;
#define BAND_STEP(ST, G_, SH_, RHO_, NB0_, IMG_, KR0_, NROWS_) \
                const int G_ = (ST) >> 2, s4_##G_ = (ST) & 3, SH_ = 2 * G_, L_##G_ = SEQ >> SH_; \
                const int RHO_ = (G_ == 0) ? 0 : (G_ == 1 ? s4_##G_ : 4 * s4_##G_);                         \
                const int NB0_ = (G_ == 0) ? 1024 * h2 + 256 * s4_##G_ : (G_ == 1 ? 256 * h2 : 0);     \
                const unsigned IMG_ = (unsigned)(3 * pg8::SZ64 + (size_t)(3 * G_) * pg8::SZ32 + ((size_t)(b * 4 + hh) * 2048 + RHO_ * L_##G_) * 64);     \
                const int KR0_ = (G_ < 2) ? NB0_ - 128 : 0, NROWS_ = (G_ < 2) ? 384 : 512;
            att::u32x4 kreg[8], vreg[8];
            { BAND_STEP(0, g0_, sh0_, rho0_, nb00_, img0_, kr00_, nrows0_) (void)sh0_; (void)rho0_; (void)nb00_;
              att::img_load(PROJ, img0_ + (unsigned)pg8::SZ32, img0_ + 2u * (unsigned)pg8::SZ32, kr00_, nrows0_, kreg, vreg, tid); }
            for (int st = 0; st < 12; ++st) {
                BAND_STEP(st, g, sh, rho, nb0, img, kr0, nrows) (void)kr0;
                __syncthreads();
                att::img_store(lds, lds + 512 * att::BP, nrows, kreg, vreg, tid);
                __syncthreads();
                if (st < 11) { BAND_STEP(st + 1, gn, shn, rhon, nb0n, imgn, kr0n, nrowsn) (void)shn; (void)rhon; (void)nb0n;
                    att::img_load(PROJ, imgn + (unsigned)pg8::SZ32, imgn + 2u * (unsigned)pg8::SZ32, kr0n, nrowsn, kreg, vreg, tid); }
                int n0, qrow, row0, kn0, ntiles, rho_w;
                if (g < 2) { n0 = nb0 + 32 * wave; qrow = n0; row0 = 32 * wave; kn0 = nb0 - 128 + 32 * wave; ntiles = 5; rho_w = rho; }
                else { const int res = wave >> 1, qt = wave & 1; n0 = 64 * h2 + 32 * qt; qrow = 128 * res + n0; row0 = 128 * res; kn0 = 0; ntiles = (n0 >> 5) + 1; rho_w = rho + res; }
                bf16* ob = OBG + (size_t)g * T * 256 + ((size_t)b * SEQ + rho_w) * 256 + hh * 64;
                float* ls = LSE + (size_t)g * T * 4 + ((size_t)b * SEQ + rho_w) * 4 + hh;
                att::band_item_lds(PROJ, img, qrow, n0, row0, kn0, ntiles, ob, (long)(256 << sh), ls, (long)(4 << sh), lds, lds + 512 * att::BP, lane);
            }
#undef BAND_STEP
            asm volatile("s_waitcnt vmcnt(0)" ::: "memory"); __syncthreads();
            for (int i = tid; i < 1024 * 8; i += NTHREADS) {
                const int ch = i & 7; const size_t t = (size_t)b * SEQ + 1024 * h2 + (i >> 3);
                const float l0 = LSE[t * 4 + hh], l1 = LSE[(size_t)T * 4 + t * 4 + hh], l2 = LSE[(size_t)2 * T * 4 + t * 4 + hh];
                const float mx = fmaxf(l0, fmaxf(l1, l2));
                float a0 = __expf(l0 - mx), a1 = __expf(l1 - mx), a2 = __expf(l2 - mx); const float is = 1.0f / (a0 + a1 + a2); a0 *= is; a1 *= is; a2 *= is;
                const size_t off = t * 256 + hh * 64 + ch * 8;
                const v4u p0 = *(const v4u*)(OBG + off), p1 = *(const v4u*)(OBG + (size_t)T * 256 + off), p2 = *(const v4u*)(OBG + (size_t)2 * T * 256 + off);
                v4u o;
                o.x = pk2(a0 * bfl(p0.x) + a1 * bfl(p1.x) + a2 * bfl(p2.x), a0 * bfh(p0.x) + a1 * bfh(p1.x) + a2 * bfh(p2.x));
                o.y = pk2(a0 * bfl(p0.y) + a1 * bfl(p1.y) + a2 * bfl(p2.y), a0 * bfh(p0.y) + a1 * bfh(p1.y) + a2 * bfh(p2.y));
                o.z = pk2(a0 * bfl(p0.z) + a1 * bfl(p1.z) + a2 * bfl(p2.z), a0 * bfh(p0.z) + a1 * bfh(p1.z) + a2 * bfh(p2.z));
                o.w = pk2(a0 * bfl(p0.w) + a1 * bfl(p1.w) + a2 * bfl(p2.w), a0 * bfh(p0.w) + a1 * bfh(p1.w) + a2 * bfh(p2.w));
                *(v4u*)(OB + t * OP + hh * 64 + ch * 8) = o;
            }
        }
        for (int c = bx; c < NB_ * 8; c += G) {
            const int b = c >> 3, hh = c & 7;
            const unsigned qb = (unsigned)((size_t)(b * 8 + hh) * 2048 * 64);
            bf16* ob = OA + (size_t)b * SEQ * OP + hh * 64;
            att::u32x4 kreg[8], vreg[8];
            att::img_load(PROJ, qb + (unsigned)pg8::SZ64, qb + 2u * (unsigned)pg8::SZ64, 0, 256, kreg, vreg, tid);
            for (int st = 0; st < 8; ++st) {
                const int n0 = 256 * st + 32 * wave, r_ = lane & 31, h_ = lane >> 5;
                att::bf16x8 qf[4]; att::f32x16 o[2]; float R = 1.0f; bool done = false;
#pragma unroll
                for (int d0 = 0; d0 < 4; ++d0) qf[d0] = *(const att::bf16x8*)((const char*)PROJ + 2u * (qb + (unsigned)((n0 + r_) * 64 + 16 * d0 + 8 * h_)));
#pragma unroll
                for (int db = 0; db < 2; ++db)
#pragma unroll
                    for (int i = 0; i < 16; ++i) o[db][i] = 0.f;
                int top = 256 * st + 256; bool first_round = true;
                for (;;) {
                    const int base_row = top > 480 ? top - 480 : 0;
                    __syncthreads();
                    if (first_round) att::img_store(lds, lds + 480 * att::BP, top - base_row, kreg, vreg, tid);
                    else att::band_fill(PROJ, qb + (unsigned)pg8::SZ64, qb + 2u * (unsigned)pg8::SZ64, base_row, top - base_row, lds, lds + 480 * att::BP, tid);
                    __syncthreads();
                    if (first_round && st < 7) { const int topn = 256 * st + 512, basen = topn > 480 ? topn - 480 : 0;
                        att::img_load(PROJ, qb + (unsigned)pg8::SZ64, qb + 2u * (unsigned)pg8::SZ64, basen, topn - basen, kreg, vreg, tid); }
                    first_round = false;
                    if (!done) { const int kb_hi = n0 < top - 32 ? n0 : top - 32;
                        done = att::stick_round_lds(qf, o, R, n0, kb_hi, base_row, lds, lds + 480 * att::BP, lane) || (base_row == 0); }
                    if (!__syncthreads_or(done ? 0 : 1)) break;
                    top = base_row;
                }
                bf16* orow = ob + (size_t)(n0 + r_) * OP;
#pragma unroll
                for (int db = 0; db < 2; ++db) att::store_o32(orow + 32 * db, o[db], 1.0f, h_);
            }
        }
        for (int c = bx; c < NB_ * 8; c += G) {
            const int b = c >> 3, hh = (c >> 1) & 3, half = c & 1;
            const bf16* qb = PROJ + 3 * pg8::SZ64 + 9 * pg8::SZ32 + (size_t)(b * 4 + hh) * 2048 * 128;
            const bf16* kb = KVM + (size_t)b * 256 * 1024 + hh * 128;
            bf16* ob = OC + (size_t)b * SEQ * OP + hh * 128;
            __syncthreads();
            att::xattn_fill(kb, kb + 512, lds, lds + 256 * att::XP, tid);
            __syncthreads();
            att::bf16x8 xq[8], xqn[8];
            att::xattn_q_load(qb, (32 * half + wave) * 32, xq, lane);
            for (int k = 0; k < 4; ++k) { const int n0 = (32 * half + wave + 8 * k) * 32;
                if (k < 3) att::xattn_q_load(qb, n0 + 256, xqn, lane);
                att::xattn_item_lds(xq, n0, 0.08838834764831845f, ob, OP, lds, lds + 256 * att::XP, lane);
#pragma unroll
                for (int d0 = 0; d0 < 8; ++d0) xq[d0] = xqn[d0]; }
        }
        __syncthreads();
    }
    GRID_BAR();

    {
        pg8::Gemm g{XN, WCAT, T, 1024, D, XNP, 4352}; pg8::P3Order S; S.S.init(T, 1024, G, bx); S.xnp = XN; S.oabc = OA; S.wcat = WCAT;
        pg8::EpiP3 E{GS, MERGED, b_gate};
        pg8::gemm_phase<pg8::EpiP3, pg8::P3Order, true, true, true>(lds, g, S, E);
    }
    GRID_BAR();

    {
        pg8::Gemm g{MERGED, WO, T, 1024, D}; pg8::StaticOrder S; S.init(T, 1024, G, bx);
        pg8::EpiPlain E{MIX, 1024};
        pg8::gemm_phase<pg8::EpiPlain, pg8::StaticOrder, true, true>(lds, g, S, E);
    }
    GRID_BAR();

    {
        for (int m0 = gw; m0 < T; m0 += 2 * NGW) {
            f32x4 v[2][4], xx[2][4]; float s[2] = {0.f, 0.f}, s2[2] = {0.f, 0.f};
#pragma unroll
            for (int u = 0; u < 2; ++u) { const int m = (m0 + u * NGW < T) ? m0 + u * NGW : m0;     const v2u* mr = (const v2u*)(MIX + (size_t)m * D) + lane; const f32x4* xr = (const f32x4*)(xin + (size_t)m * D) + lane;
#pragma unroll
                for (int j = 0; j < 4; ++j) { const v2u w = mr[64 * j]; xx[u][j] = xr[64 * j]; v[u][j] = (f32x4){bfl(w.x), bfh(w.x), bfl(w.y), bfh(w.y)}; } }
#pragma unroll
            for (int u = 0; u < 2; ++u)
#pragma unroll
                for (int j = 0; j < 4; ++j) s[u] += (v[u][j].x * v[u][j].x + v[u][j].y * v[u][j].y) + (v[u][j].z * v[u][j].z + v[u][j].w * v[u][j].w);
#pragma unroll
            for (int u = 0; u < 2; ++u) { const float rstd = 1.0f / sqrtf(wave_sum(s[u]) * (1.0f / D) + EPS);
#pragma unroll
                for (int j = 0; j < 4; ++j) { const f32x4 gg = ((const f32x4*)g_post_mix + lane)[64 * j]; v[u][j] = xx[u][j] + v[u][j] * rstd * gg; s2[u] += (v[u][j].x * v[u][j].x + v[u][j].y * v[u][j].y) + (v[u][j].z * v[u][j].z + v[u][j].w * v[u][j].w); } }
#pragma unroll
            for (int u = 0; u < 2; ++u) { const float rstd2 = 1.0f / sqrtf(wave_sum(s2[u]) * (1.0f / D) + EPS); unsigned long long* o8 = (unsigned long long*)(XN2 + (size_t)((m0 + u * NGW < T) ? m0 + u * NGW : m0) * D) + lane;
#pragma unroll
                for (int j = 0; j < 4; ++j) { const f32x4 gg = ((const f32x4*)g_pre_ffn + lane)[64 * j];
                    o8[64 * j] = (unsigned long long)pk2(v[u][j].x * rstd2 * gg.x, v[u][j].y * rstd2 * gg.y) | ((unsigned long long)pk2(v[u][j].z * rstd2 * gg.z, v[u][j].w * rstd2 * gg.w) << 32); } }
        }
    }
    GRID_BAR();

    {
        pg8::Gemm g{XN2, WFI, T, 2 * DFF, D}; pg8::StaticOrder S; S.init(T, 2 * DFF, G, bx);
        pg8::EpiSwiglu E{FB};
        pg8::gemm_phase<pg8::EpiSwiglu, pg8::StaticOrder, true, true>(lds, g, S, E);
    }
    GRID_BAR();

    {
        pg8::Gemm g{FB, WFO, T, 1024, DFF}; pg8::StaticOrder S; S.init(T, 1024, G, bx);
        pg8::EpiPlain E{FO, 1024};
        pg8::gemm_phase<pg8::EpiPlain, pg8::StaticOrder, true, true>(lds, g, S, E);
    }
    GRID_BAR();

    {
        for (int m0 = gw; m0 < T; m0 += 2 * NGW) {
            f32x4 v[2][4], f[2][4], xx[2][4]; float s[2] = {0.f, 0.f}, s3[2] = {0.f, 0.f};
#pragma unroll
            for (int u = 0; u < 2; ++u) { const int m = (m0 + u * NGW < T) ? m0 + u * NGW : m0;     const v2u* mr = (const v2u*)(MIX + (size_t)m * D) + lane; const v2u* fr_ = (const v2u*)(FO + (size_t)m * D) + lane; const f32x4* xr = (const f32x4*)(xin + (size_t)m * D) + lane;
#pragma unroll
                for (int j = 0; j < 4; ++j) { const v2u w = mr[64 * j], q = fr_[64 * j]; xx[u][j] = xr[64 * j];
                    v[u][j] = (f32x4){bfl(w.x), bfh(w.x), bfl(w.y), bfh(w.y)}; f[u][j] = (f32x4){bfl(q.x), bfh(q.x), bfl(q.y), bfh(q.y)}; } }
#pragma unroll
            for (int u = 0; u < 2; ++u)
#pragma unroll
                for (int j = 0; j < 4; ++j) { s[u] += (v[u][j].x * v[u][j].x + v[u][j].y * v[u][j].y) + (v[u][j].z * v[u][j].z + v[u][j].w * v[u][j].w); s3[u] += (f[u][j].x * f[u][j].x + f[u][j].y * f[u][j].y) + (f[u][j].z * f[u][j].z + f[u][j].w * f[u][j].w); }
#pragma unroll
            for (int u = 0; u < 2; ++u) { const float rstd = 1.0f / sqrtf(wave_sum(s[u]) * (1.0f / D) + EPS), rstd3 = 1.0f / sqrtf(wave_sum(s3[u]) * (1.0f / D) + EPS);
                f32x4* xo = (f32x4*)(a.out + (size_t)((m0 + u * NGW < T) ? m0 + u * NGW : m0) * D) + lane;
#pragma unroll
                for (int j = 0; j < 4; ++j) { const f32x4 g1 = ((const f32x4*)g_post_mix + lane)[64 * j], g3 = ((const f32x4*)g_post_ffn + lane)[64 * j];
                    xo[64 * j] = (xx[u][j] + v[u][j] * rstd * g1) + f[u][j] * rstd3 * g3; } }
        }
    }
}

extern "C" void kernel_launch(void* const* d_in, const int* in_sizes, int n_in, void* d_out, int out_size, void* d_ws, size_t ws_size, hipStream_t stream) {
    static int grid = 0;
    if (grid == 0) {
        if (n_in != 17 || in_sizes[0] != T * D || out_size != T * D || ws_size < 971 * MiB) { fprintf(stderr, "kernel_launch: unexpected shapes / workspace (n_in %d, in0 %d, out %d, ws %zu, need %zu)\n", n_in, n_in > 0 ? in_sizes[0] : -1, out_size, ws_size, (size_t)WS_END); grid = -1; return; }
        int dev = 0, cus = 0, per_cu = 0;
        hipGetDevice(&dev); hipDeviceGetAttribute(&cus, hipDeviceAttributeMultiprocessorCount, dev);
        if (hipFuncSetAttribute((const void*)fwd_megakernel, hipFuncAttributeMaxDynamicSharedMemorySize, LDS_BYTES) != hipSuccess) { fprintf(stderr, "kernel_launch: hipFuncSetAttribute failed\n"); grid = -1; return; }
        if (hipOccupancyMaxActiveBlocksPerMultiprocessor(&per_cu, (const void*)fwd_megakernel, NTHREADS, LDS_BYTES) != hipSuccess || per_cu < 1) { fprintf(stderr, "kernel_launch: occupancy query says %d blocks per CU\n", per_cu); per_cu = 1; }
        (void)hipGetLastError();
        grid = cus * 1;
    }
    if (grid < 0) return;
    Args a{};
    for (int i = 0; i < 17; ++i) a.in[i] = (const float*)d_in[i];
    a.out = (float*)d_out; a.ws = (unsigned char*)d_ws;
    void* args[] = {&a};
    hipError_t e = hipLaunchCooperativeKernel((const void*)fwd_megakernel, dim3(grid), dim3(NTHREADS), args, LDS_BYTES, stream);
    if (e != hipSuccess) fprintf(stderr, "kernel_launch: cooperative launch failed: %s (grid %d)\n", hipGetErrorString(e), grid);
}
```

```cpp
#include <hip/hip_runtime.h>
#include <hip/hip_cooperative_groups.h>
#include <cstdio>
#include <cstdint>
namespace cg = cooperative_groups;
namespace pg8 {
#define PG8_LAS __attribute__((address_space(3)))
typedef unsigned short bf16_t;
typedef short bf16x8 __attribute__((ext_vector_type(8)));
typedef float f32x4 __attribute__((ext_vector_type(4)));
typedef unsigned u32x4 __attribute__((ext_vector_type(4)));
constexpr int BM = 256, BK = 64, HALF = 128, HTB = HALF * BK * 2  , STAGE_BYTES = 8 * HTB, NXCD = 8, WGM = 8;

__host__ __device__ __forceinline__ int lds_byte(int r, int c) { const int st = (r >> 4) * 2 + (c >> 5), rr = r & 15, cc = c & 31, ob = rr * 64 + cc * 2; return st * 1024 + (ob ^ (((ob >> 9) & 1) << 5)); }
__host__ __device__ __forceinline__ void stage_rc(int b, int& R, int& C) { const int st = b / 1024, sb = b % 1024, swz = sb ^ (((sb >> 9) & 1) << 5); R = (st >> 1) * 16 + swz / 64; C = (st & 1) * 32 + (swz % 64) / 2; }
__host__ __device__ __forceinline__ int perm32(int rho) { const int n = rho >> 4, i = rho & 15; return 8 * (i >> 2) + 4 * n + (i & 3); }

struct Unit { int pm, pn; const bf16_t* A = nullptr; const bf16_t* Bt = nullptr; int nt = 0, step = 0; };
struct Gemm { const bf16_t* A; const bf16_t* Bt; int M, N, K; int lda = 0, ldb = 0; };

struct StaticOrder {
    int nM, nN, nwg, G, c;
    __host__ __device__ void init(int M, int N, int G_, int c_) { nM = M / BM; nN = N / BM; nwg = nM * nN; G = G_; c = c_; }
    __host__ __device__ bool next(int i, Unit& u) const {
        const long L = (long)i * G + c; if (L >= nwg) return false;
        int wgid = (int)L; { const int q = nwg / NXCD, r = nwg % NXCD, xcd = wgid % NXCD, off = wgid / NXCD; wgid = (xcd < r ? xcd * (q + 1) : r * (q + 1) + (xcd - r) * q) + off; }
        const int nig = WGM * nN, gid = wgid / nig, fm = gid * WGM, gsz = (nM - fm) < WGM ? (nM - fm) : WGM;
        u.pm = fm + ((wgid % nig) % gsz); u.pn = (wgid % nig) / gsz; return true;
    }
    __device__ __forceinline__ void a_ready(const Unit&) const {}
    __device__ __forceinline__ void done(const Unit&) const {}
};

typedef float f32x2 __attribute__((ext_vector_type(2)));
typedef __bf16 pg8_bf16x2 __attribute__((ext_vector_type(2)));
__device__ __forceinline__ unsigned cvt_pk_bf16(float lo, float hi) { f32x2 v = {lo, hi}; pg8_bf16x2 b = __builtin_convertvector(v, pg8_bf16x2); return __builtin_bit_cast(unsigned, b); }
typedef unsigned u32x2 __attribute__((ext_vector_type(2)));
__device__ __forceinline__ float bf_lo(unsigned w) { return __uint_as_float(w << 16); }
__device__ __forceinline__ float bf_hi(unsigned w) { return __uint_as_float(w & 0xffff0000u); }
__device__ __forceinline__ float sigmoidf_fast(float v) { return __builtin_amdgcn_rcpf(1.0f + __builtin_amdgcn_exp2f(-1.4426950408889634f * v)); }
__device__ __forceinline__ u32x4 pack8(const f32x4 v0, const f32x4 v1) { u32x4 w; w.x = cvt_pk_bf16(v0[0], v0[1]); w.y = cvt_pk_bf16(v0[2], v0[3]); w.z = cvt_pk_bf16(v1[0], v1[1]); w.w = cvt_pk_bf16(v1[2], v1[3]); return w; }

__device__ __forceinline__ u32x4 ld16_agent(const bf16_t* p) { const unsigned long long* q = (const unsigned long long*)p;
    const unsigned long long a = __hip_atomic_load(q, __ATOMIC_RELAXED, __HIP_MEMORY_SCOPE_AGENT), b = __hip_atomic_load(q + 1, __ATOMIC_RELAXED, __HIP_MEMORY_SCOPE_AGENT);
    u32x4 r; r.x = (unsigned)a; r.y = (unsigned)(a >> 32); r.z = (unsigned)b; r.w = (unsigned)(b >> 32); return r; }
struct EpiPlain {
    static constexpr bool PERM = true, AFTER_DRAIN = false;
    bf16_t* O; int ldc;
    __device__ __forceinline__ void operator()(const f32x4 (&acc)[2][2][4][2], const Unit& u, int wr, int wc, int fr, int fq) const {
        const int row0 = u.pm * BM + wr * 64 + fr, col0 = u.pn * BM + wc * 32 + 8 * fq;
#pragma unroll
        for (int ai = 0; ai < 2; ++ai)
#pragma unroll
            for (int m = 0; m < 4; ++m) { bf16_t* rowp = O + (size_t)(row0 + ai * HALF + m * 16) * ldc + col0;
#pragma unroll
                for (int bj = 0; bj < 2; ++bj) *(u32x4*)(rowp + bj * HALF) = pack8(acc[ai][bj][m][0], acc[ai][bj][m][1]); }
    }
};
constexpr size_t SZ64 = 33554432ull, SZ32 = 16777216ull;
__device__ __forceinline__ size_t proj_off(int pn, int row, int cl) {
    const int b = row >> 11, s = row & 2047;
    if (pn < 6) { const int kind = pn >> 1, c = (pn & 1) * 256 + cl, hh = c >> 6, dd = c & 63; return (size_t)kind * SZ64 + ((size_t)(b * 8 + hh) * 2048 + s) * 64 + dd; }
    if (pn < 15) { const int gk = pn - 6, g = gk / 3, hh = cl >> 6, dd = cl & 63, sh = 2 * g, rho = s & ((1 << sh) - 1), n = s >> sh, L = 2048 >> sh;
        return 3 * SZ64 + (size_t)gk * SZ32 + ((size_t)(b * 4 + hh) * 2048 + rho * L + n) * 64 + dd; }
    { const int c = (pn - 15) * 256 + cl, hh = c >> 7, dd = c & 127; return 3 * SZ64 + 9 * SZ32 + ((size_t)(b * 4 + hh) * 2048 + s) * 128 + dd; }
}
struct EpiProj {
    static constexpr bool PERM = true, AFTER_DRAIN = false;
    bf16_t* O; const float* rope;
    __device__ __forceinline__ void operator()(const f32x4 (&acc)[2][2][4][2], const Unit& u, int wr, int wc, int fr, int fq) const {
        const int pn = u.pn;
        const int dg = pn - 6;
        const bool dil = (dg >= 0 && dg < 9);
        const bool is_rope = dil && (dg % 3) != 2;
        const float sc = (pn < 2 || (dil && (dg % 3) == 0)) ? 0.125f : 1.0f;
        const int row0 = u.pm * BM + wr * 64 + fr, cl0 = wc * 32 + 8 * fq;
#pragma unroll
        for (int ai = 0; ai < 2; ++ai)
#pragma unroll
            for (int m = 0; m < 4; ++m) { const int row = row0 + ai * HALF + m * 16; const int pos = row & 2047;
                const size_t po = proj_off(pn, row, cl0);
#pragma unroll
                for (int bj = 0; bj < 2; ++bj) { f32x4 v0 = acc[ai][bj][m][0], v1 = acc[ai][bj][m][1];
                    if (is_rope) { const int jb = ((cl0 + bj * HALF) & 63) >> 1;
                        const f32x4 c0 = *(const f32x4*)(rope + (size_t)(pos * 32 + jb) * 2), c1 = *(const f32x4*)(rope + (size_t)(pos * 32 + jb + 2) * 2);
                        f32x4 t0, t1;
                        t0[0] = v0[0] * c0[0] - v0[1] * c0[1]; t0[1] = v0[1] * c0[0] + v0[0] * c0[1]; t0[2] = v0[2] * c0[2] - v0[3] * c0[3]; t0[3] = v0[3] * c0[2] + v0[2] * c0[3];
                        t1[0] = v1[0] * c1[0] - v1[1] * c1[1]; t1[1] = v1[1] * c1[0] + v1[0] * c1[1]; t1[2] = v1[2] * c1[2] - v1[3] * c1[3]; t1[3] = v1[3] * c1[2] + v1[2] * c1[3];
                        v0 = t0; v1 = t1; }
                    v0 = v0 * sc; v1 = v1 * sc;
                    *(u32x4*)(O + po + (size_t)bj * 262144) = pack8(v0, v1); } }
    }
};
struct EpiGate {
    static constexpr bool PERM = true, AFTER_DRAIN = false;
    bf16_t* O; const float* bias;
    __device__ __forceinline__ void operator()(const f32x4 (&acc)[2][2][4][2], const Unit& u, int wr, int wc, int fr, int fq) const {
        const int row0 = u.pm * BM + wr * 64 + fr, col0 = u.pn * BM + wc * 32 + 8 * fq;
        f32x4 bv[2][2];
#pragma unroll
        for (int bj = 0; bj < 2; ++bj)
#pragma unroll
            for (int n = 0; n < 2; ++n) bv[bj][n] = *(const f32x4*)(bias + col0 + bj * HALF + 4 * n);
#pragma unroll
        for (int ai = 0; ai < 2; ++ai)
#pragma unroll
            for (int m = 0; m < 4; ++m) { bf16_t* rowp = O + (size_t)(row0 + ai * HALF + m * 16) * 1024 + col0;
#pragma unroll
                for (int bj = 0; bj < 2; ++bj) { f32x4 v0 = acc[ai][bj][m][0] + bv[bj][0], v1 = acc[ai][bj][m][1] + bv[bj][1];
#pragma unroll
                    for (int e = 0; e < 4; ++e) { v0[e] = sigmoidf_fast(v0[e]); v1[e] = sigmoidf_fast(v1[e]); }
                    *(u32x4*)(rowp + bj * HALF) = pack8(v0, v1); } }
    }
};
template <bool FIRST> struct EpiBranch {
    static constexpr bool PERM = true, AFTER_DRAIN = false;
    bf16_t* MG; const bf16_t* GS;
    __device__ __forceinline__ void operator()(const f32x4 (&acc)[2][2][4][2], const Unit& u, int wr, int wc, int fr, int fq) const {
        const int row0 = u.pm * BM + wr * 64 + fr, col0 = u.pn * BM + wc * 32 + 8 * fq;
#pragma unroll
        for (int ai = 0; ai < 2; ++ai)
#pragma unroll
            for (int m = 0; m < 4; ++m) { const size_t off = (size_t)(row0 + ai * HALF + m * 16) * 1024 + col0;
#pragma unroll
                for (int bj = 0; bj < 2; ++bj) { const u32x4 g = ld16_agent(GS + off + bj * HALF);
                    f32x4 v0 = acc[ai][bj][m][0], v1 = acc[ai][bj][m][1];
                    v0[0] *= bf_lo(g.x); v0[1] *= bf_hi(g.x); v0[2] *= bf_lo(g.y); v0[3] *= bf_hi(g.y);
                    v1[0] *= bf_lo(g.z); v1[1] *= bf_hi(g.z); v1[2] *= bf_lo(g.w); v1[3] *= bf_hi(g.w);
                    if (!FIRST) { const u32x4 p = ld16_agent(MG + off + bj * HALF);
                        v0[0] += bf_lo(p.x); v0[1] += bf_hi(p.x); v0[2] += bf_lo(p.y); v0[3] += bf_hi(p.y);
                        v1[0] += bf_lo(p.z); v1[1] += bf_hi(p.z); v1[2] += bf_lo(p.w); v1[3] += bf_hi(p.w); }
                    *(u32x4*)(MG + off + bj * HALF) = pack8(v0, v1); } }
    }
};
struct EpiSwiglu {
    static constexpr bool PERM = true, AFTER_DRAIN = false;
    bf16_t* O;
    __device__ __forceinline__ void operator()(const f32x4 (&acc)[2][2][4][2], const Unit& u, int wr, int wc, int fr, int fq) const {
        const int row0 = u.pm * BM + wr * 64 + fr, col0 = u.pn * HALF + wc * 32 + 8 * fq;
#pragma unroll
        for (int ai = 0; ai < 2; ++ai)
#pragma unroll
            for (int m = 0; m < 4; ++m) { bf16_t* rowp = O + (size_t)(row0 + ai * HALF + m * 16) * 2816 + col0;
                f32x4 v0, v1;
#pragma unroll
                for (int e = 0; e < 4; ++e) { const float g0 = acc[ai][0][m][0][e], g1 = acc[ai][0][m][1][e];
                    v0[e] = g0 * sigmoidf_fast(g0) * acc[ai][1][m][0][e]; v1[e] = g1 * sigmoidf_fast(g1) * acc[ai][1][m][1][e]; }
                *(u32x4*)rowp = pack8(v0, v1); }
    }
};

struct P3Order {
    StaticOrder S; const bf16_t* xnp; const bf16_t* oabc; const bf16_t* wcat;
    __device__ __forceinline__ bool next(int i, Unit& u) const {
        if (!S.next(i / 6, u)) return false;
        const int st = i % 6, br = st >> 1; u.step = st;
        if (st & 1) { u.A = xnp; u.Bt = wcat + br * 1024; u.nt = 16; }
        else { const int co = (br == 0) ? 0 : (br == 1 ? 512 : 768); u.A = oabc + co; u.Bt = wcat + 3072 + co; u.nt = (br == 1) ? 4 : 8; }
        return true;
    }
    __device__ __forceinline__ void a_ready(const Unit&) const {}
    __device__ __forceinline__ void done(const Unit&) const {}
};
struct EpiP3 {
    static constexpr bool PERM = true, AFTER_DRAIN = false;
    bf16_t* YS; bf16_t* MG; const float* bias;
    __device__ __forceinline__ void operator()(const f32x4 (&acc)[2][2][4][2], const Unit& u, int wr, int wc, int fr, int fq) const {
        const int row0 = u.pm * BM + wr * 64 + fr, col0 = u.pn * BM + wc * 32 + 8 * fq;
        if ((u.step & 1) == 0) {
#pragma unroll
            for (int ai = 0; ai < 2; ++ai)
#pragma unroll
                for (int m = 0; m < 4; ++m) { bf16_t* rowp = YS + (size_t)(row0 + ai * HALF + m * 16) * 1024 + col0;
#pragma unroll
                    for (int bj = 0; bj < 2; ++bj) *(u32x4*)(rowp + bj * HALF) = pack8(acc[ai][bj][m][0], acc[ai][bj][m][1]); }
        } else {
            const int br = u.step >> 1; const bool first = (br == 0);
            f32x4 bv[2][2];
#pragma unroll
            for (int bj = 0; bj < 2; ++bj)
#pragma unroll
                for (int n = 0; n < 2; ++n) bv[bj][n] = *(const f32x4*)(bias + br * 1024 + col0 + bj * HALF + 4 * n);
#pragma unroll
            for (int ai = 0; ai < 2; ++ai)
#pragma unroll
                for (int m = 0; m < 4; ++m) { const size_t off = (size_t)(row0 + ai * HALF + m * 16) * 1024 + col0;
#pragma unroll
                    for (int bj = 0; bj < 2; ++bj) { const u32x4 y = *(const u32x4*)(YS + off + bj * HALF);
                        f32x4 v0 = acc[ai][bj][m][0] + bv[bj][0], v1 = acc[ai][bj][m][1] + bv[bj][1];
#pragma unroll
                        for (int e = 0; e < 4; ++e) { v0[e] = sigmoidf_fast(v0[e]); v1[e] = sigmoidf_fast(v1[e]); }
                        v0[0] *= bf_lo(y.x); v0[1] *= bf_hi(y.x); v0[2] *= bf_lo(y.y); v0[3] *= bf_hi(y.y);
                        v1[0] *= bf_lo(y.z); v1[1] *= bf_hi(y.z); v1[2] *= bf_lo(y.w); v1[3] *= bf_hi(y.w);
                        if (!first) { const u32x4 p = *(const u32x4*)(MG + off + bj * HALF);
                            v0[0] += bf_lo(p.x); v0[1] += bf_hi(p.x); v0[2] += bf_lo(p.y); v0[3] += bf_hi(p.y);
                            v1[0] += bf_lo(p.z); v1[1] += bf_hi(p.z); v1[2] += bf_lo(p.w); v1[3] += bf_hi(p.w); }
                        *(u32x4*)(MG + off + bj * HALF) = pack8(v0, v1); } }
        }
    }
};
template <class Epi, class Sched, bool ALIGN_EPI = false, bool SP2 = false, bool MULTI = false>
__device__ __forceinline__ void gemm_phase(PG8_LAS unsigned char* lds, const Gemm g, const Sched& S, const Epi& E) {
    int tid_ = threadIdx.x; asm volatile("" : "+v"(tid_));
    const int tid = tid_, wid = __builtin_amdgcn_readfirstlane(tid >> 6), lane = tid & 63, wr = wid >> 2, wc = wid & 3, fr = lane & 15, fq = lane >> 4;
    const int lda = g.lda ? g.lda : g.K, ldb = g.ldb ? g.ldb : g.K; int nt = g.K / BK;
    unsigned voffA[2], voffB[2];
#pragma unroll
    for (int i = 0; i < 2; ++i) { int R, C; stage_rc(tid * 16 + i * 8192, R, C); const int Rb = Epi::PERM ? ((R & ~31) + perm32(R & 31)) : R;
        voffA[i] = (unsigned)(R * lda + C) * 2u; voffB[i] = (unsigned)(Rb * ldb + C) * 2u; }
    const size_t kstep = (size_t)(BK * 2);
    const size_t hstepA = (size_t)HALF * lda * 2, hstepB = (size_t)HALF * ldb * 2;
    const size_t tstepA = 2 * hstepA, tstepB = 2 * hstepB;
    const unsigned ldsw = (unsigned)wid * 1024u;
    const int aoff = lds_byte(wr * 64 + fr, fq * 8), boff = lds_byte(wc * 32 + fr, fq * 8);
#define PG8_SA(b, h) (((b) * 2 + (h)) * HTB)
#define PG8_SB(b, h) ((4 + (b) * 2 + (h)) * HTB)
#define PG8_STAGE(bufoff, gbase, voff) do { _Pragma("unroll") for (int _i = 0; _i < 2; ++_i) \
        __builtin_amdgcn_global_load_lds((const unsigned*)((const char*)(gbase) + (voff)[_i]), (PG8_LAS unsigned*)(lds + (bufoff) + ldsw + _i * 8192), 16, 0, 1); } while (0)
#define PG8_LDA(dst, b, h) do { _Pragma("unroll") for (int m = 0; m < 4; ++m) _Pragma("unroll") for (int k = 0; k < 2; ++k) dst[m][k] = *(const PG8_LAS bf16x8*)(lds + PG8_SA(b, h) + aoff + m * 2048 + k * 1024); } while (0)
#define PG8_LDB(dst, b, h) do { _Pragma("unroll") for (int n = 0; n < 2; ++n) _Pragma("unroll") for (int k = 0; k < 2; ++k) dst[n][k] = *(const PG8_LAS bf16x8*)(lds + PG8_SB(b, h) + boff + n * 2048 + k * 1024); } while (0)
#define PG8_MMA(ai, bj, At, Bt) do { __builtin_amdgcn_s_setprio(1); _Pragma("unroll") for (int m = 0; m < 4; ++m) _Pragma("unroll") for (int n = 0; n < 2; ++n) _Pragma("unroll") for (int k = 0; k < 2; ++k) \
        acc[ai][bj][m][n] = __builtin_amdgcn_mfma_f32_16x16x32_bf16(Bt[n][k], At[m][k], acc[ai][bj][m][n], 0, 0, 0); __builtin_amdgcn_s_setprio(0); } while (0)
#define PG8_WAIT_V(n) asm volatile("s_waitcnt vmcnt(" #n ")" ::: "memory")
#define PG8_WAIT_L(n) asm volatile("s_waitcnt lgkmcnt(" #n ")" ::: "memory")
#define PG8_BAR __builtin_amdgcn_s_barrier()
#define PG8_SCHED __builtin_amdgcn_sched_barrier(0)
    Unit cur, nxt; int ui = 0;
    if (!S.next(0, cur)) return;
    f32x4 acc[2][2][4][2];
#pragma unroll
    for (int a = 0; a < 2; ++a)
#pragma unroll
        for (int b = 0; b < 2; ++b)
#pragma unroll
            for (int m = 0; m < 4; ++m)
#pragma unroll
                for (int n = 0; n < 2; ++n) acc[a][b][m][n] = (f32x4){0.f, 0.f, 0.f, 0.f};
    bf16x8 At[4][2], B0[2][2], B1[2][2];
    if constexpr (MULTI) nt = cur.nt;
    const char* cA = (const char*)(MULTI ? cur.A : g.A) + (size_t)cur.pm * tstepA; const char* cB = (const char*)(MULTI ? cur.Bt : g.Bt) + (size_t)cur.pn * tstepB;
    S.a_ready(cur);
    if constexpr (SP2) {
        PG8_STAGE(PG8_SB(0, 0), cB, voffB); PG8_STAGE(PG8_SB(0, 1), cB + hstepB, voffB); PG8_STAGE(PG8_SA(0, 0), cA, voffA); PG8_STAGE(PG8_SA(0, 1), cA + hstepA, voffA);
        if (wr == 1) PG8_BAR;
        PG8_WAIT_V(2); PG8_BAR;
        PG8_STAGE(PG8_SB(1, 0), cB + kstep, voffB); PG8_STAGE(PG8_SA(1, 0), cA + kstep, voffA); PG8_STAGE(PG8_SB(1, 1), cB + hstepB + kstep, voffB);
        PG8_WAIT_V(6); PG8_BAR;
    } else {
        PG8_STAGE(PG8_SB(0, 0), cB, voffB); PG8_STAGE(PG8_SA(0, 0), cA, voffA); PG8_STAGE(PG8_SB(0, 1), cB + hstepB, voffB); PG8_STAGE(PG8_SA(0, 1), cA + hstepA, voffA);
        if (wr == 1) PG8_BAR;
        PG8_WAIT_V(4); PG8_BAR;
        PG8_STAGE(PG8_SB(1, 0), cB + kstep, voffB); PG8_STAGE(PG8_SA(1, 0), cA + kstep, voffA); PG8_STAGE(PG8_SB(1, 1), cB + hstepB + kstep, voffB);
        PG8_WAIT_V(6); PG8_BAR;
    }
    for (;;) {
        const bool has_next = S.next(ui + 1, nxt);
        const char* nA = has_next ? (const char*)(MULTI ? nxt.A : g.A) + (size_t)nxt.pm * tstepA : cA; const char* nB = has_next ? (const char*)(MULTI ? nxt.Bt : g.Bt) + (size_t)nxt.pn * tstepB : cB;
        for (int t = 0; t < nt; t += 2) {
            const bool last = (t == nt - 2);
            const char* a1 = cA + (size_t)(t + 1) * kstep;
            const char* a2 = last ? nA : cA + (size_t)(t + 2) * kstep; const char* b2 = last ? nB : cB + (size_t)(t + 2) * kstep;
            const char* a3 = a2 + kstep; const char* b3 = b2 + kstep;
            if (last && has_next) S.a_ready(nxt);
            if constexpr (SP2) {
            PG8_LDB(B0, 0, 0); PG8_LDB(B1, 0, 1); PG8_SCHED; PG8_LDA(At, 0, 0); PG8_STAGE(PG8_SA(1, 1), a1 + hstepA, voffA);
            PG8_WAIT_V(8); PG8_WAIT_L(0); PG8_BAR; PG8_MMA(0, 0, At, B0); PG8_MMA(0, 1, At, B1); PG8_BAR; PG8_SCHED;
            PG8_LDA(At, 0, 1); PG8_STAGE(PG8_SB(0, 0), b2, voffB); PG8_STAGE(PG8_SB(0, 1), b2 + hstepB, voffB); PG8_STAGE(PG8_SA(0, 0), a2, voffA);
            PG8_WAIT_V(8); PG8_WAIT_L(0); PG8_BAR; PG8_MMA(1, 0, At, B0); PG8_MMA(1, 1, At, B1); PG8_BAR; PG8_SCHED;
            PG8_LDB(B0, 1, 0); PG8_LDB(B1, 1, 1); PG8_SCHED; PG8_LDA(At, 1, 0); PG8_STAGE(PG8_SA(0, 1), a2 + hstepA, voffA);
            PG8_WAIT_V(8); PG8_WAIT_L(0); PG8_BAR; PG8_MMA(0, 0, At, B0); PG8_MMA(0, 1, At, B1); PG8_BAR; PG8_SCHED;
            PG8_LDA(At, 1, 1); PG8_STAGE(PG8_SB(1, 0), b3, voffB); PG8_STAGE(PG8_SB(1, 1), b3 + hstepB, voffB); PG8_STAGE(PG8_SA(1, 0), a3, voffA);
            PG8_WAIT_V(8); PG8_WAIT_L(0); PG8_BAR; PG8_MMA(1, 0, At, B0); PG8_MMA(1, 1, At, B1); PG8_BAR; PG8_SCHED;
            } else {
            PG8_LDB(B0, 0, 0); PG8_SCHED; PG8_LDA(At, 0, 0); PG8_STAGE(PG8_SA(1, 1), a1 + hstepA, voffA);
            PG8_WAIT_L(8); PG8_BAR; PG8_WAIT_L(0); PG8_MMA(0, 0, At, B0); PG8_BAR; PG8_SCHED;
            PG8_LDB(B1, 0, 1); PG8_STAGE(PG8_SB(0, 0), b2, voffB);
            PG8_BAR; PG8_WAIT_L(0); PG8_MMA(0, 1, At, B1); PG8_BAR;
            PG8_LDA(At, 0, 1); PG8_STAGE(PG8_SA(0, 0), a2, voffA);
            PG8_BAR; PG8_WAIT_L(0); PG8_MMA(1, 0, At, B0); PG8_BAR; PG8_SCHED;
            PG8_STAGE(PG8_SB(0, 1), b2 + hstepB, voffB);
            PG8_WAIT_V(6); PG8_BAR; PG8_MMA(1, 1, At, B1); PG8_BAR;
            PG8_LDB(B0, 1, 0); PG8_SCHED; PG8_LDA(At, 1, 0); PG8_STAGE(PG8_SA(0, 1), a2 + hstepA, voffA);
            PG8_WAIT_L(8); PG8_BAR; PG8_WAIT_L(0); PG8_MMA(0, 0, At, B0); PG8_BAR; PG8_SCHED;
            PG8_LDB(B1, 1, 1); PG8_STAGE(PG8_SB(1, 0), b3, voffB);
            PG8_BAR; PG8_WAIT_L(0); PG8_MMA(0, 1, At, B1); PG8_BAR;
            PG8_LDA(At, 1, 1); PG8_STAGE(PG8_SA(1, 0), a3, voffA);
            PG8_BAR; PG8_WAIT_L(0); PG8_MMA(1, 0, At, B0); PG8_BAR; PG8_SCHED;
            PG8_STAGE(PG8_SB(1, 1), b3 + hstepB, voffB);
            PG8_WAIT_V(6); PG8_BAR; PG8_MMA(1, 1, At, B1); PG8_BAR;
            }
        }
        if constexpr (ALIGN_EPI) { if (wr == 0) PG8_BAR; }
        if constexpr (!Epi::AFTER_DRAIN) { E(acc, cur, wr, wc, fr, fq); S.done(cur); }
        if (!has_next) break;
#pragma unroll
        for (int a = 0; a < 2; ++a)
#pragma unroll
            for (int b = 0; b < 2; ++b)
#pragma unroll
                for (int m = 0; m < 4; ++m)
#pragma unroll
                    for (int n = 0; n < 2; ++n) acc[a][b][m][n] = (f32x4){0.f, 0.f, 0.f, 0.f};
        cur = nxt; cA = nA; cB = nB; ++ui; if constexpr (MULTI) nt = cur.nt;
        if constexpr (ALIGN_EPI) { if (wr == 1) PG8_BAR; }
    }
    PG8_WAIT_V(0);
    if constexpr (!ALIGN_EPI) { if (wr == 0) PG8_BAR; }
    PG8_BAR;
    if constexpr (Epi::AFTER_DRAIN) { E.fused(acc, cur, wr, wc, fr, fq, lds, wid, lane); S.done(cur); }
#undef PG8_SA
#undef PG8_SB
#undef PG8_STAGE
#undef PG8_LDA
#undef PG8_LDB
#undef PG8_MMA
#undef PG8_WAIT_V
#undef PG8_WAIT_L
#undef PG8_BAR
#undef PG8_SCHED
}
}
namespace att {
#define LAS __attribute__((address_space(3)))
typedef unsigned short bf16_t;
typedef short bf16x8 __attribute__((ext_vector_type(8)));
typedef short s16x4 __attribute__((ext_vector_type(4)));
typedef float f32x16 __attribute__((ext_vector_type(16)));
typedef float f32x2 __attribute__((ext_vector_type(2)));
typedef __bf16 bf16x2_t __attribute__((ext_vector_type(2)));
typedef unsigned u32x4 __attribute__((ext_vector_type(4)));
typedef unsigned u32x2 __attribute__((ext_vector_type(2)));
#define MFMA32(a, b, c) __builtin_amdgcn_mfma_f32_32x32x16_bf16((a), (b), (c), 0, 0, 0)
__device__ __forceinline__ int crow(int reg, int h) { return (reg & 3) + 8 * (reg >> 2) + 4 * h; }
__device__ __forceinline__ unsigned cvtpk(float lo, float hi) { f32x2 v = {lo, hi}; bf16x2_t b = __builtin_convertvector(v, bf16x2_t); return __builtin_bit_cast(unsigned, b); }
__device__ __forceinline__ float xhalf(float v, int h) { auto rr = __builtin_amdgcn_permlane32_swap(__float_as_uint(v), __float_as_uint(v), false, false); return __uint_as_float(h ? rr[0] : rr[1]); }
__device__ __forceinline__ float xmax(float v) { auto rr = __builtin_amdgcn_permlane32_swap(__float_as_uint(v), __float_as_uint(v), false, false); return __builtin_fmaxf(__uint_as_float(rr[0]), __uint_as_float(rr[1])); }
__device__ __forceinline__ float xsum(float v) { auto rr = __builtin_amdgcn_permlane32_swap(__float_as_uint(v), __float_as_uint(v), false, false); return __uint_as_float(rr[0]) + __uint_as_float(rr[1]); }
__device__ __forceinline__ s16x4 vtr(const LAS unsigned char* p) { return __builtin_bit_cast(s16x4, __builtin_amdgcn_ds_read_tr16_b64_v4i16((LAS s16x4*)p)); }

__device__ __forceinline__ void store_o32(bf16_t* __restrict__ rowblk, const f32x16& o, float inv, int h) {
#pragma unroll
    for (int gp = 0; gp < 2; ++gp) {
        const unsigned a0 = cvtpk(o[8 * gp] * inv, o[8 * gp + 1] * inv), a1 = cvtpk(o[8 * gp + 2] * inv, o[8 * gp + 3] * inv);
        const unsigned b0 = cvtpk(o[8 * gp + 4] * inv, o[8 * gp + 5] * inv), b1 = cvtpk(o[8 * gp + 6] * inv, o[8 * gp + 7] * inv);
        auto s0 = __builtin_amdgcn_permlane32_swap(a0, b0, false, false);
        auto s1 = __builtin_amdgcn_permlane32_swap(a1, b1, false, false);
        u32x4 w; w.x = s0[0]; w.y = s1[0]; w.z = s0[1]; w.w = s1[1];
        *(u32x4*)(rowblk + 16 * gp + 8 * h) = w; }
}
enum { MODE_XATTN = 0, MODE_BAND = 1, MODE_STICK = 2 };
#define ATT_LOAD_K(KB, KTX, KF) do { const int key0_ = (KTX) * KT; \
        _Pragma("unroll") for (int hf = 0; hf < NH; ++hf) { const unsigned ko = 2u * ((KB) + (unsigned)((key0_ + 32 * hf + r) * DH + 8 * h)); \
            _Pragma("unroll") for (int d0 = 0; d0 < ND; ++d0) KF[hf][d0] = *(const bf16x8*)((const char*)base + (ko + 32u * d0)); } } while (0)
#define ATT_LOAD_V(VB, KTX, VV) do { const int key0_ = (KTX) * KT; \
        _Pragma("unroll") for (int i = 0; i < NCH; ++i) { const int c = i * 64 + lane, row = c / CPR, ch = c % CPR; const int vr = key0_ + row; \
            VV[i] = *(const u32x4*)((const char*)base + 2u * ((VB) + (unsigned)(vr * DH + ch * 8))); } } while (0)
#define ATT_LOAD_Q(QB, N0, QF) do { _Pragma("unroll") for (int d0 = 0; d0 < ND; ++d0) QF[d0] = *(const bf16x8*)((const char*)base + 2u * ((QB) + (unsigned)(((N0) + r) * DH + 16 * d0 + 8 * h))); } while (0)
template <int DH, int KT>
__device__ __forceinline__ void att_prime(const bf16_t* __restrict__ base, unsigned Q, unsigned K, unsigned V, int n0, int kt_hi,
                                          bf16x8 (&qf)[DH / 16], bf16x8 (&kf)[KT / 32][DH / 16], u32x4 (&vv)[KT * (DH / 8) / 64], int lane) {
    constexpr int ND = DH / 16, NH = KT / 32, CPR = DH / 8, NCH = KT * CPR / 64;
    const int r = lane & 31, h = lane >> 5;
    ATT_LOAD_Q(Q, n0, qf); ATT_LOAD_K(K, kt_hi, kf); ATT_LOAD_V(V, kt_hi, vv);
}
template <int DH, int KT, int MODE>
__device__ __forceinline__ void attn_item(const bf16_t* __restrict__ base, unsigned K, unsigned V,
                                          int n0, int kt_hi, int kt_lo, float sscale, bf16_t* __restrict__ O, long o_rs, float* __restrict__ lse, long lse_rs,
                                          LAS unsigned char* vimg, int lane,
                                          bf16x8 (&qf)[DH / 16], bf16x8 (&kf)[KT / 32][DH / 16], u32x4 (&vv)[KT * (DH / 8) / 64],
                                          bool has_next, unsigned Qn, unsigned Kn, unsigned Vn, int n0n, int kt_hi_n) {
    constexpr int ND = DH / 16, NH = KT / 32, NB = DH / 32, VP = DH * 2 + 16, CPR = DH / 8, NCH = KT * CPR / 64;
    constexpr bool PFV = true;
    const int r = lane & 31, h = lane >> 5;
    f32x16 o[NB];
#pragma unroll
    for (int db = 0; db < NB; ++db)
#pragma unroll
        for (int i = 0; i < 16; ++i) o[db][i] = 0.f;
    float m_run = -1e30f, l_run = 0.f, R = 1.0f;
    const int qn = n0 + r;
    const LAS unsigned char* vrd = vimg + (4 * h + ((lane & 15) >> 2)) * VP + ((lane >> 4) & 1) * 32 + (lane & 3) * 8;
    bool primed_next = false;
    for (int kt = kt_hi; kt >= kt_lo; --kt) {
        const int key0 = kt * KT;
        if (PFV) { asm volatile("s_waitcnt lgkmcnt(0)" ::: "memory");
#pragma unroll
            for (int i = 0; i < NCH; ++i) { const int c = i * 64 + lane, row = c / CPR, ch = c % CPR; *(LAS u32x4*)(vimg + row * VP + ch * 16) = vv[i]; } }
        f32x16 p[NH];
#pragma unroll
        for (int hf = 0; hf < NH; ++hf) {
#pragma unroll
            for (int i = 0; i < 16; ++i) p[hf][i] = 0.f;
#pragma unroll
            for (int d0 = 0; d0 < ND; ++d0) p[hf] = MFMA32(kf[hf][d0], qf[d0], p[hf]); }
        if (kt > kt_lo) { ATT_LOAD_K(K, kt - 1, kf); ATT_LOAD_V(V, kt - 1, vv); }
        else if (has_next) { ATT_LOAD_Q(Qn, n0n, qf); ATT_LOAD_K(Kn, kt_hi_n, kf); ATT_LOAD_V(Vn, kt_hi_n, vv); primed_next = true; }
        if (MODE == MODE_STICK) {
            float run = R;
#pragma unroll
            for (int hf = NH - 1; hf >= 0; --hf) {
                float beta[16], keep[16];
#pragma unroll
                for (int i = 0; i < 16; ++i) { const float z = __builtin_fmaxf(p[hf][i], -87.0f);
                    const float e = __builtin_amdgcn_exp2f(-1.4426950408889634f * z); const float rr = __builtin_amdgcn_rcpf(1.0f + e);
                    beta[i] = rr; keep[i] = e * rr; }
                if (kt == kt_hi) {
#pragma unroll
                    for (int i = 0; i < 16; ++i) { const int kn = key0 + 32 * hf + crow(i, h); if (kn >= qn) { beta[i] = 0.f; keep[i] = 1.0f; } }
                }
                float G[4], PG[4];
#pragma unroll
                for (int g = 0; g < 4; ++g) { G[g] = (keep[4 * g] * keep[4 * g + 1]) * (keep[4 * g + 2] * keep[4 * g + 3]); PG[g] = xhalf(G[g], h); }
#pragma unroll
                for (int g = 3; g >= 0; --g) {
                    const float c3 = (h == 0) ? run * PG[g] : run;
                    const float c2 = c3 * keep[4 * g + 3], c1 = c2 * keep[4 * g + 2], c0 = c1 * keep[4 * g + 1];
                    p[hf][4 * g + 3] = beta[4 * g + 3] * c3; p[hf][4 * g + 2] = beta[4 * g + 2] * c2; p[hf][4 * g + 1] = beta[4 * g + 1] * c1; p[hf][4 * g] = beta[4 * g] * c0;
                    run = run * (G[g] * PG[g]); }
                __builtin_amdgcn_sched_barrier(0);
            }
            R = run;
        } else {
            const float c2 = (MODE == MODE_XATTN ? sscale : 1.0f) * 1.4426950408889634f;
            float tmax = -1e30f;
            const bool need_mask = (MODE == MODE_BAND) && (kt == kt_hi || key0 < n0 + 31 - 128);
            if (need_mask) { const int dlt = key0 + 4 * h - qn;
#pragma unroll
                for (int hf = 0; hf < NH; ++hf)
#pragma unroll
                    for (int i = 0; i < 16; ++i) { const int dd = dlt + 32 * hf + (i & 3) + 8 * (i >> 2); float s = p[hf][i] * c2; if ((unsigned)(dd + 128) > 128u) s = -1e30f; p[hf][i] = s; tmax = __builtin_fmaxf(tmax, s); }
            } else {
#pragma unroll
                for (int hf = 0; hf < NH; ++hf)
#pragma unroll
                    for (int i = 0; i < 16; ++i) { const float s = p[hf][i] * c2; p[hf][i] = s; tmax = __builtin_fmaxf(tmax, s); }
            }
            tmax = xmax(tmax);
            const float m_new = __builtin_fmaxf(m_run, tmax);
            const float alpha = __builtin_amdgcn_exp2f(m_run - m_new);
            m_run = m_new; l_run *= alpha;
            float ls = 0.f;
#pragma unroll
            for (int hf = 0; hf < NH; ++hf)
#pragma unroll
                for (int i = 0; i < 16; ++i) { const float e = __builtin_amdgcn_exp2f(p[hf][i] - m_new); p[hf][i] = e; ls += e; }
            l_run += ls;
#pragma unroll
            for (int db = 0; db < NB; ++db)
#pragma unroll
                for (int i = 0; i < 16; ++i) o[db][i] *= alpha;
        }
        if (!PFV) { asm volatile("s_waitcnt lgkmcnt(0)" ::: "memory");
#pragma unroll
            for (int i = 0; i < NCH; ++i) { const int c = i * 64 + lane, row = c / CPR, ch = c % CPR; *(LAS u32x4*)(vimg + row * VP + ch * 16) = vv[i]; } }
        asm volatile("s_waitcnt lgkmcnt(0)" ::: "memory");
#pragma unroll
        for (int s = 0; s < KT / 16; ++s) { const int hf = s >> 1, sb = (s & 1) * 8;
            u32x4 pw; pw.x = cvtpk(p[hf][sb], p[hf][sb + 1]); pw.y = cvtpk(p[hf][sb + 2], p[hf][sb + 3]); pw.z = cvtpk(p[hf][sb + 4], p[hf][sb + 5]); pw.w = cvtpk(p[hf][sb + 6], p[hf][sb + 7]);
            const bf16x8 pf = __builtin_bit_cast(bf16x8, pw);
#pragma unroll
            for (int db = 0; db < NB; ++db) { const s16x4 lo = vtr(vrd + (16 * s) * VP + db * 64), hi = vtr(vrd + (16 * s + 8) * VP + db * 64);
                const bf16x8 vf = __builtin_shufflevector(lo, hi, 0, 1, 2, 3, 4, 5, 6, 7);
                o[db] = MFMA32(vf, pf, o[db]); } }
        if (MODE == MODE_STICK) { if (__all(R == 0.0f)) break; }
    }
    float inv = 1.0f;
    if (MODE != MODE_STICK) { const float lt = xsum(l_run); inv = 1.0f / lt;
        if (MODE == MODE_BAND) { if (h == 0) lse[(long)qn * lse_rs] = (m_run + __builtin_log2f(lt)) * 0.6931471805599453f; } }
    bf16_t* orow = O + (long)qn * o_rs + 4 * h;
#pragma unroll
    for (int db = 0; db < NB; ++db)
#pragma unroll
        for (int g = 0; g < 4; ++g) { u32x2 w; w.x = cvtpk(o[db][4 * g] * inv, o[db][4 * g + 1] * inv); w.y = cvtpk(o[db][4 * g + 2] * inv, o[db][4 * g + 3] * inv);
            *(u32x2*)(orow + 32 * db + 8 * g) = w; }
    if (has_next && !primed_next) { ATT_LOAD_Q(Qn, n0n, qf); ATT_LOAD_K(Kn, kt_hi_n, kf); ATT_LOAD_V(Vn, kt_hi_n, vv); }
}

constexpr int XP = 272;
__device__ __forceinline__ void xattn_fill(const bf16_t* __restrict__ Kg, const bf16_t* __restrict__ Vg, LAS unsigned char* kimg, LAS unsigned char* vimg_all, int tid_) {
#pragma unroll
    for (int i = 0; i < 8; ++i) { const int c = i * 512 + tid_, row = c >> 4, ch = c & 15;
        const u32x4 kv = *(const u32x4*)(Kg + (long)row * 1024 + ch * 8), vv = *(const u32x4*)(Vg + (long)row * 1024 + ch * 8);
        *(LAS u32x4*)(kimg + row * XP + ch * 16) = kv; *(LAS u32x4*)(vimg_all + row * XP + ch * 16) = vv; }
}
__device__ __forceinline__ void xattn_q_load(const bf16_t* __restrict__ Q, int n0, bf16x8 (&qf)[8], int lane) {
    const int r = lane & 31, h = lane >> 5;
#pragma unroll
    for (int d0 = 0; d0 < 8; ++d0) qf[d0] = *(const bf16x8*)(Q + (long)(n0 + r) * 128 + 16 * d0 + 8 * h);
}
__device__ __forceinline__ void xattn_item_lds(const bf16x8 (&qf)[8], int n0, float sscale, bf16_t* __restrict__ O, long o_rs, const LAS unsigned char* kimg, const LAS unsigned char* vimg_all, int lane) {
    constexpr int DH = 128, ND = 8, NB = 4;
    const int r = lane & 31, h = lane >> 5;
    f32x16 o[NB];
#pragma unroll
    for (int db = 0; db < NB; ++db)
#pragma unroll
        for (int i = 0; i < 16; ++i) o[db][i] = 0.f;
    float m_run = -1e30f, l_run = 0.f;
    const LAS unsigned char* krd = kimg + r * XP + 16 * h;
    const LAS unsigned char* vrd = vimg_all + (4 * h + ((lane & 15) >> 2)) * XP + ((lane >> 4) & 1) * 32 + (lane & 3) * 8;
    const float c2 = sscale * 1.4426950408889634f;
    for (int kt = 0; kt < 8; ++kt) {
        f32x16 p;
#pragma unroll
        for (int i = 0; i < 16; ++i) p[i] = 0.f;
#pragma unroll
        for (int d0 = 0; d0 < ND; ++d0) { const bf16x8 kf = *(const LAS bf16x8*)(krd + kt * 32 * XP + d0 * 32); p = MFMA32(kf, qf[d0], p); }
        float tmax = -1e30f;
#pragma unroll
        for (int i = 0; i < 16; ++i) { p[i] *= c2; tmax = __builtin_fmaxf(tmax, p[i]); }
        tmax = xmax(tmax);
        if (__any(tmax > m_run + 8.0f)) { const float m_new = __builtin_fmaxf(m_run, tmax), alpha = __builtin_amdgcn_exp2f(m_run - m_new); m_run = m_new; l_run *= alpha;
#pragma unroll
            for (int db = 0; db < NB; ++db)
#pragma unroll
                for (int i = 0; i < 16; ++i) o[db][i] *= alpha; }
        float ls = 0.f;
#pragma unroll
        for (int i = 0; i < 16; ++i) { const float e = __builtin_amdgcn_exp2f(p[i] - m_run); p[i] = e; ls += e; }
        l_run += ls;
#pragma unroll
        for (int s = 0; s < 2; ++s) { const int sb = s * 8;
            u32x4 pw; pw.x = cvtpk(p[sb], p[sb + 1]); pw.y = cvtpk(p[sb + 2], p[sb + 3]); pw.z = cvtpk(p[sb + 4], p[sb + 5]); pw.w = cvtpk(p[sb + 6], p[sb + 7]);
            const bf16x8 pf = __builtin_bit_cast(bf16x8, pw);
#pragma unroll
            for (int db = 0; db < NB; ++db) { const s16x4 lo = vtr(vrd + (kt * 32 + 16 * s) * XP + db * 64), hi = vtr(vrd + (kt * 32 + 16 * s + 8) * XP + db * 64);
                const bf16x8 vf = __builtin_shufflevector(lo, hi, 0, 1, 2, 3, 4, 5, 6, 7);
                o[db] = MFMA32(vf, pf, o[db]); } }
    }
    const float inv = 1.0f / xsum(l_run);
    bf16_t* orow = O + (long)(n0 + r) * o_rs;
#pragma unroll
    for (int db = 0; db < NB; ++db) store_o32(orow + 32 * db, o[db], inv, h);
}

constexpr int BP = 144;
__device__ __forceinline__ void band_fill(const bf16_t* __restrict__ base, unsigned Ko, unsigned Vo, int kr0, int nrows, LAS unsigned char* kimg, LAS unsigned char* vimg2, int tid_) {
    for (int c = tid_; c < nrows * 8; c += 512) { const int row = c >> 3, ch = c & 7; const unsigned eo = (unsigned)((kr0 + row) * 64 + ch * 8);
        const u32x4 kv = *(const u32x4*)((const char*)base + 2u * (Ko + eo)), vv = *(const u32x4*)((const char*)base + 2u * (Vo + eo));
        *(LAS u32x4*)(kimg + row * BP + ch * 16) = kv; *(LAS u32x4*)(vimg2 + row * BP + ch * 16) = vv; }
}

__device__ __forceinline__ void img_load(const bf16_t* __restrict__ base, unsigned Ko, unsigned Vo, int kr0, int nrows, u32x4 (&kreg)[8], u32x4 (&vreg)[8], int tid_) {
#pragma unroll
    for (int i = 0; i < 8; ++i) { const int c = i * 512 + tid_; if (c < nrows * 8) { const int row = c >> 3, ch = c & 7; const unsigned eo = (unsigned)((kr0 + row) * 64 + ch * 8);
        kreg[i] = *(const u32x4*)((const char*)base + 2u * (Ko + eo)); vreg[i] = *(const u32x4*)((const char*)base + 2u * (Vo + eo)); } }
}
__device__ __forceinline__ void img_store(LAS unsigned char* kimg, LAS unsigned char* vimg2, int nrows, const u32x4 (&kreg)[8], const u32x4 (&vreg)[8], int tid_) {
#pragma unroll
    for (int i = 0; i < 8; ++i) { const int c = i * 512 + tid_; if (c < nrows * 8) { const int row = c >> 3, ch = c & 7;
        *(LAS u32x4*)(kimg + row * BP + ch * 16) = kreg[i]; *(LAS u32x4*)(vimg2 + row * BP + ch * 16) = vreg[i]; } }
}
__device__ __forceinline__ void band_item_lds(const bf16_t* __restrict__ base, unsigned Qo, int qrow, int n0, int row0, int kn0, int ntiles, bf16_t* __restrict__ O, long o_rs, float* __restrict__ lse, long lse_rs,
                                              const LAS unsigned char* kimg, const LAS unsigned char* vimg2, int lane) {
    const int r = lane & 31, h = lane >> 5;
    bf16x8 qf[4];
#pragma unroll
    for (int d0 = 0; d0 < 4; ++d0) qf[d0] = *(const bf16x8*)((const char*)base + 2u * (Qo + (unsigned)((qrow + r) * 64 + 16 * d0 + 8 * h)));
    f32x16 o[2];
#pragma unroll
    for (int db = 0; db < 2; ++db)
#pragma unroll
        for (int i = 0; i < 16; ++i) o[db][i] = 0.f;
    float m_run = -1e30f, l_run = 0.f;
    const int qn = n0 + r; const unsigned lo = (unsigned)(qn < 128 ? qn : 128);
    const LAS unsigned char* krd = kimg + (row0 + r) * BP + 16 * h;
    const LAS unsigned char* vrd = vimg2 + (row0 + 4 * h + ((lane & 15) >> 2)) * BP + ((lane >> 4) & 1) * 32 + (lane & 3) * 8;
    for (int j = ntiles - 1; j >= 0; --j) {
        const int key0 = kn0 + 32 * j;
        if (key0 + 31 < 0) break;
        f32x16 p;
#pragma unroll
        for (int i = 0; i < 16; ++i) p[i] = 0.f;
#pragma unroll
        for (int d0 = 0; d0 < 4; ++d0) { const bf16x8 kf = *(const LAS bf16x8*)(krd + j * 32 * BP + d0 * 32); p = MFMA32(kf, qf[d0], p); }
        float tmax = -1e30f;
        const bool need_mask = (j == ntiles - 1) || (key0 < n0 + 31 - 128) || (key0 < 0);
        if (need_mask) { const int dlt = key0 + 4 * h - qn;
#pragma unroll
            for (int i = 0; i < 16; ++i) { const int dd = dlt + (i & 3) + 8 * (i >> 2); float sv = p[i] * 1.4426950408889634f; if ((unsigned)(dd + (int)lo) > lo) sv = -1e30f; p[i] = sv; tmax = __builtin_fmaxf(tmax, sv); }
        } else {
#pragma unroll
            for (int i = 0; i < 16; ++i) { const float sv = p[i] * 1.4426950408889634f; p[i] = sv; tmax = __builtin_fmaxf(tmax, sv); }
        }
        tmax = xmax(tmax);
        if (__any(tmax > m_run + 8.0f)) { const float m_new = __builtin_fmaxf(m_run, tmax), alpha = __builtin_amdgcn_exp2f(m_run - m_new); m_run = m_new; l_run *= alpha;
#pragma unroll
            for (int db = 0; db < 2; ++db)
#pragma unroll
                for (int i = 0; i < 16; ++i) o[db][i] *= alpha; }
        float ls = 0.f;
#pragma unroll
        for (int i = 0; i < 16; ++i) { const float e = __builtin_amdgcn_exp2f(p[i] - m_run); p[i] = e; ls += e; }
        l_run += ls;
#pragma unroll
        for (int s = 0; s < 2; ++s) { const int sb = s * 8;
            u32x4 pw; pw.x = cvtpk(p[sb], p[sb + 1]); pw.y = cvtpk(p[sb + 2], p[sb + 3]); pw.z = cvtpk(p[sb + 4], p[sb + 5]); pw.w = cvtpk(p[sb + 6], p[sb + 7]);
            const bf16x8 pf = __builtin_bit_cast(bf16x8, pw);
#pragma unroll
            for (int db = 0; db < 2; ++db) { const s16x4 lo4 = vtr(vrd + (j * 32 + 16 * s) * BP + db * 64), hi4 = vtr(vrd + (j * 32 + 16 * s + 8) * BP + db * 64);
                const bf16x8 vf = __builtin_shufflevector(lo4, hi4, 0, 1, 2, 3, 4, 5, 6, 7);
                o[db] = MFMA32(vf, pf, o[db]); } }
    }
    const float lt = xsum(l_run), inv = 1.0f / lt;
    if (h == 0) lse[(long)qn * lse_rs] = (m_run + __builtin_log2f(lt)) * 0.6931471805599453f;
    bf16_t* orow = O + (long)qn * o_rs;
#pragma unroll
    for (int db = 0; db < 2; ++db) store_o32(orow + 32 * db, o[db], inv, h);
}

__device__ __forceinline__ bool stick_round_lds(const bf16x8 (&qf)[4], f32x16 (&o)[2], float& R, int n0, int kb_hi, int base_row, const LAS unsigned char* kimg, const LAS unsigned char* vimg2, int lane) {
    const int r = lane & 31, h = lane >> 5, qn = n0 + r;
    const LAS unsigned char* krd = kimg + r * BP + 16 * h;
    const LAS unsigned char* vrd = vimg2 + (4 * h + ((lane & 15) >> 2)) * BP + ((lane >> 4) & 1) * 32 + (lane & 3) * 8;
    for (int kb = kb_hi; kb >= base_row; kb -= 32) {
        const int ro = kb - base_row;
        f32x16 p;
#pragma unroll
        for (int i = 0; i < 16; ++i) p[i] = 0.f;
#pragma unroll
        for (int d0 = 0; d0 < 4; ++d0) { const bf16x8 kf = *(const LAS bf16x8*)(krd + ro * BP + d0 * 32); p = MFMA32(kf, qf[d0], p); }
        float beta[16], keep[16];
#pragma unroll
        for (int i = 0; i < 16; ++i) { const float z = __builtin_fmaxf(p[i], -87.0f); const float e = __builtin_amdgcn_exp2f(-1.4426950408889634f * z); const float rr = __builtin_amdgcn_rcpf(1.0f + e); beta[i] = rr; keep[i] = e * rr; }
        if (kb == n0) {
#pragma unroll
            for (int i = 0; i < 16; ++i) { const int kn = kb + crow(i, h); if (kn >= qn) { beta[i] = 0.f; keep[i] = 1.0f; } }
        }
        float G[4], PG[4];
#pragma unroll
        for (int g = 0; g < 4; ++g) { G[g] = (keep[4 * g] * keep[4 * g + 1]) * (keep[4 * g + 2] * keep[4 * g + 3]); PG[g] = xhalf(G[g], h); }
        float run = R;
#pragma unroll
        for (int g = 3; g >= 0; --g) {
            const float c3 = (h == 0) ? run * PG[g] : run;
            const float c2 = c3 * keep[4 * g + 3], c1 = c2 * keep[4 * g + 2], c0 = c1 * keep[4 * g + 1];
            p[4 * g + 3] = beta[4 * g + 3] * c3; p[4 * g + 2] = beta[4 * g + 2] * c2; p[4 * g + 1] = beta[4 * g + 1] * c1; p[4 * g] = beta[4 * g] * c0;
            run = run * (G[g] * PG[g]); }
        R = run;
#pragma unroll
        for (int s = 0; s < 2; ++s) { const int sb = s * 8;
            u32x4 pw; pw.x = cvtpk(p[sb], p[sb + 1]); pw.y = cvtpk(p[sb + 2], p[sb + 3]); pw.z = cvtpk(p[sb + 4], p[sb + 5]); pw.w = cvtpk(p[sb + 6], p[sb + 7]);
            const bf16x8 pf = __builtin_bit_cast(bf16x8, pw);
#pragma unroll
            for (int db = 0; db < 2; ++db) { const s16x4 lo4 = vtr(vrd + (ro + 16 * s) * BP + db * 64), hi4 = vtr(vrd + (ro + 16 * s + 8) * BP + db * 64);
                const bf16x8 vf = __builtin_shufflevector(lo4, hi4, 0, 1, 2, 3, 4, 5, 6, 7);
                o[db] = MFMA32(vf, pf, o[db]); } }
        if (__all(R == 0.0f)) return true;
    }
    return false;
}
#undef ATT_LOAD_K
#undef ATT_LOAD_V
#undef ATT_LOAD_Q
#undef LAS
}
#define LAS __attribute__((address_space(3)))
typedef unsigned short bf16;
typedef unsigned v4u __attribute__((ext_vector_type(4)));
typedef unsigned v2u __attribute__((ext_vector_type(2)));
typedef float f32x4 __attribute__((ext_vector_type(4)));
constexpr int NWAVES = 8, NTHREADS = 512;
constexpr int T = 65536, D = 1024, SEQ = 2048, NB_ = 32, DIN = 4352, DFF = 2816, MEMT = 8192;
constexpr float EPS = 1e-6f;
constexpr int XNP = 1280, OP = 1280;
constexpr size_t MiB = 1u << 20;
constexpr size_t OFF_WIN = 0;
constexpr size_t OFF_WGATE = OFF_WIN + 4352ull * 1024 * 2;
constexpr size_t OFF_WSB = OFF_WGATE + 3072ull * 1024 * 2;
constexpr size_t OFF_WDIL = OFF_WSB + 1024ull * 512 * 2;
constexpr size_t OFF_WMEM = OFF_WDIL + 1024ull * 256 * 2;
constexpr size_t OFF_WO = OFF_WMEM + 1024ull * 512 * 2;
constexpr size_t OFF_WFI = OFF_WO + 1024ull * 1024 * 2;
constexpr size_t OFF_WFO = OFF_WFI + 5632ull * 1024 * 2;
constexpr size_t OFF_WKV = OFF_WFO + 1024ull * 2816 * 2;
constexpr size_t OFF_ROPE = OFF_WKV + 1024ull * 1024 * 2;
constexpr size_t OFF_MEMN = OFF_ROPE + 2048ull * 64 * 4;
constexpr size_t OFF_KVM = OFF_MEMN + 8192ull * 1024 * 2;
constexpr size_t OFF_R1 = 72 * MiB;
constexpr size_t OFF_R2 = OFF_R1 + 544 * MiB;
constexpr size_t WS_END = OFF_R2 + 352 * MiB;
static_assert(OFF_KVM + 8192ull * 1024 * 2 <= OFF_R1, "ws map");
constexpr size_t OFF_PROJ = OFF_R1, OFF_GS = OFF_R1, OFF_MERGED = OFF_R1 + 128 * MiB, OFF_XN2 = OFF_R1 + 256 * MiB, OFF_FO = OFF_R1 + 384 * MiB;
constexpr size_t OFF_OBG = OFF_R2, OFF_LSE = OFF_R2 + 96 * MiB, OFF_OA = OFF_R2 + 100 * MiB, OFF_OB = OFF_R2 + 164 * MiB, OFF_OC = OFF_R2 + 196 * MiB, OFF_MIX = OFF_R1, OFF_F = OFF_R2;
constexpr int LDS_BYTES = 147456;

__device__ __forceinline__ unsigned f2bf(float f) { unsigned u = __builtin_bit_cast(unsigned, f); return (u + 0x7fffu + ((u >> 16) & 1u)) >> 16; }
__device__ __forceinline__ unsigned pk2(float lo, float hi) { return f2bf(lo) | (f2bf(hi) << 16); }
__device__ __forceinline__ float wave_sum(float v) {
#pragma unroll
    for (int o = 1; o < 64; o <<= 1) v += __shfl_xor(v, o);
    return v;
}
template <int MAP> __device__ __forceinline__ int map_row(int n) {
    if (MAP == 1) { if (n >= 1536 && n < 3840 && (((n - 1536) >> 8) % 3) != 2) return (n & ~63) + 2 * (n & 31) + ((n >> 5) & 1); return n; }
    if (MAP == 2) { const int f = n < DFF ? n : n - DFF; return (f >> 7) * 256 + (n < DFF ? 0 : 128) + (f & 127); }
    return n;
}
template <int MAP> __device__ __forceinline__ void transpose_item(const float* __restrict__ W, int K, int N, bf16* __restrict__ WT, int ldw, int coff, LAS float* scr, int item, int lane_) {
    const int nblk = N / 32, kb = item / nblk, nb = item % nblk, k0 = 64 * kb, n0 = 32 * nb;
#pragma unroll 8
    for (int i = 0; i < 32; ++i) { const int kk = 2 * i + (lane_ >> 5); scr[kk * 33 + (lane_ & 31)] = W[(size_t)(k0 + kk) * N + n0 + (lane_ & 31)]; }
    asm volatile("s_waitcnt lgkmcnt(0)" ::: "memory");
    const int c = lane_ & 7;
#pragma unroll
    for (int j = 0; j < 4; ++j) { const int n = (lane_ >> 3) + 8 * j; const LAS float* s = scr + (8 * c) * 33 + n;
        v4u o; o.x = pk2(s[0 * 33], s[1 * 33]); o.y = pk2(s[2 * 33], s[3 * 33]); o.z = pk2(s[4 * 33], s[5 * 33]); o.w = pk2(s[6 * 33], s[7 * 33]);
        const int nn = n0 + n; const size_t dst = (MAP == 3) ? (size_t)(nn & 1023) * ldw + (nn >> 10) * 1024 : (size_t)map_row<MAP>(nn) * ldw + coff;
        *(v4u*)(WT + dst + k0 + 8 * c) = o; }
    asm volatile("s_waitcnt lgkmcnt(0)" ::: "memory");
}
__device__ __forceinline__ void rms_row_to_bf16(const float* __restrict__ xrow, const float* __restrict__ g, bf16* __restrict__ orow, int lane) {
    const f32x4* xr = (const f32x4*)xrow + lane; const f32x4* gr = (const f32x4*)g + lane;
    f32x4 v[4]; float s = 0.f;
#pragma unroll
    for (int j = 0; j < 4; ++j) { v[j] = xr[64 * j]; s += (v[j].x * v[j].x + v[j].y * v[j].y) + (v[j].z * v[j].z + v[j].w * v[j].w); }
    const float rstd = 1.0f / sqrtf(wave_sum(s) * (1.0f / D) + EPS);
    unsigned long long* o8 = (unsigned long long*)orow + lane;
#pragma unroll
    for (int j = 0; j < 4; ++j) { const f32x4 gg = gr[64 * j];
        o8[64 * j] = (unsigned long long)pk2(v[j].x * rstd * gg.x, v[j].y * rstd * gg.y) | ((unsigned long long)pk2(v[j].z * rstd * gg.z, v[j].w * rstd * gg.w) << 32); }
}
__device__ __forceinline__ void rms_row2_to_bf16(const float* __restrict__ xa, const float* __restrict__ xb, const float* __restrict__ g, bf16* __restrict__ oa, bf16* __restrict__ ob, int lane_) {
    const f32x4* ra = (const f32x4*)xa + lane_; const f32x4* rb = (const f32x4*)xb + lane_; const f32x4* gr = (const f32x4*)g + lane_;
    f32x4 va[4], vb[4]; float sa = 0.f, sb = 0.f;
#pragma unroll
    for (int j = 0; j < 4; ++j) { va[j] = __builtin_nontemporal_load(ra + 64 * j); vb[j] = __builtin_nontemporal_load(rb + 64 * j); }
#pragma unroll
    for (int j = 0; j < 4; ++j) { sa += (va[j].x * va[j].x + va[j].y * va[j].y) + (va[j].z * va[j].z + va[j].w * va[j].w); sb += (vb[j].x * vb[j].x + vb[j].y * vb[j].y) + (vb[j].z * vb[j].z + vb[j].w * vb[j].w); }
    const float rsa = 1.0f / sqrtf(wave_sum(sa) * (1.0f / D) + EPS), rsb = 1.0f / sqrtf(wave_sum(sb) * (1.0f / D) + EPS);
    unsigned long long* pa = (unsigned long long*)oa + lane_; unsigned long long* pb = (unsigned long long*)ob + lane_;
#pragma unroll
    for (int j = 0; j < 4; ++j) { const f32x4 gg = gr[64 * j];
        pa[64 * j] = (unsigned long long)pk2(va[j].x * rsa * gg.x, va[j].y * rsa * gg.y) | ((unsigned long long)pk2(va[j].z * rsa * gg.z, va[j].w * rsa * gg.w) << 32);
        pb[64 * j] = (unsigned long long)pk2(vb[j].x * rsb * gg.x, vb[j].y * rsb * gg.y) | ((unsigned long long)pk2(vb[j].z * rsb * gg.z, vb[j].w * rsb * gg.w) << 32); }
}
__device__ __forceinline__ float bfl(unsigned w) { return __uint_as_float(w << 16); }
__device__ __forceinline__ float bfh(unsigned w) { return __uint_as_float(w & 0xffff0000u); }

#define XB_TMO      128
#define XB_XCNT(j)  (256  + 64 * (j))
#define XB_XSUB(j)  (1280 + 64 * (j))
#define XB_XGEN(j)  (2304 + 64 * (j))
#define XB_TOP      3328
#define XB_TOPGEN   3392
#define XCD_BAR_WORDS 3456
#define XB_SPIN_CAP (1u << 18)

__device__ __forceinline__ unsigned xb_ld(unsigned* p)              { return __hip_atomic_load(p, __ATOMIC_RELAXED, __HIP_MEMORY_SCOPE_AGENT); }
__device__ __forceinline__ unsigned xb_add(unsigned* p, unsigned v) { return __hip_atomic_fetch_add(p, v, __ATOMIC_RELAXED, __HIP_MEMORY_SCOPE_AGENT); }
__device__ __forceinline__ unsigned xb_xcc_id() { return (unsigned)__builtin_amdgcn_s_getreg((3 << 11) | 20) & 0xFu; }
#define XB_SPIN(cond, bar) do { unsigned _sp = 0; while (cond) { __builtin_amdgcn_s_sleep(1); \
    if ((++_sp & 255u) == 0u) { if (xb_ld(&(bar)[XB_TMO])) break; if (_sp > XB_SPIN_CAP) { atomicAdd(&(bar)[XB_TMO], 1u); break; } } } } while (0)

struct XcdBarrier {
    unsigned* bar; unsigned x;
    volatile LAS unsigned* st;
};

__device__ __forceinline__ XcdBarrier xcd_barrier_post(unsigned* bar, volatile LAS unsigned* st) {
    XcdBarrier b; b.bar = bar; b.x = xb_xcc_id(); b.st = st;
    if (threadIdx.x == 0) (void)xb_add(&bar[XB_XCNT(b.x)], 1u);
    return b;
}
__device__ __forceinline__ void xcd_barrier_complete(unsigned* bar, unsigned x, unsigned& nloc, unsigned& nx) {
    const unsigned G = gridDim.x * gridDim.y * gridDim.z;
    unsigned sum, cnt, mine, sp = 0u;
    for (;;) {
        sum = 0u; cnt = 0u; mine = 0u;
#pragma unroll
        for (unsigned j = 0; j < 16; ++j) { const unsigned c = xb_ld(&bar[XB_XCNT(j)]); sum += c; cnt += (c > 0u) ? 1u : 0u; mine = (j == x) ? c : mine; }
        if (sum == G) break;
        __builtin_amdgcn_s_sleep(1);
        if ((++sp & 255u) == 0u) { if (xb_ld(&bar[XB_TMO])) break; if (sp > XB_SPIN_CAP) { atomicAdd(&bar[XB_TMO], 1u); break; } }
    }
    nloc = mine > 0u ? mine : 1u; nx = cnt > 0u ? cnt : 1u;
}

__device__ __forceinline__ void xcd_barrier(const XcdBarrier& b) {
    asm volatile("s_waitcnt vmcnt(0)" ::: "memory");
    __syncthreads();
    if (threadIdx.x == 0) {
        unsigned* bar = b.bar;
        __builtin_amdgcn_s_waitcnt(0);
        unsigned nloc = b.st[0], nx = b.st[1];
        if (nloc == 0u) { xcd_barrier_complete(bar, b.x, nloc, nx); b.st[0] = nloc; b.st[1] = nx; }
        const unsigned old = xb_add(&bar[XB_XSUB(b.x)], 1u);
        const unsigned gen = old / nloc;
        if (old + 1u == (gen + 1u) * nloc) {
            __builtin_amdgcn_fence(__ATOMIC_RELEASE, "agent");
            asm volatile("s_waitcnt vmcnt(0)" ::: "memory");
            const unsigned og = xb_add(&bar[XB_TOP], 1u);
            const unsigned tg = og / nx;
            if (og + 1u == (tg + 1u) * nx) xb_add(&bar[XB_TOPGEN], 1u);
            else XB_SPIN(xb_ld(&bar[XB_TOPGEN]) == tg, bar);
            __builtin_amdgcn_fence(__ATOMIC_ACQUIRE, "agent");
            xb_add(&bar[XB_XGEN(b.x)], 1u);
            asm volatile("s_waitcnt vmcnt(0)" ::: "memory");
        } else {
            XB_SPIN(xb_ld(&bar[XB_XGEN(b.x)]) == gen, bar);
            __builtin_amdgcn_fence(__ATOMIC_ACQUIRE, "agent");
            asm volatile("s_waitcnt vmcnt(0)" ::: "memory");
        }
    }
    __syncthreads();
}

constexpr size_t OFF_BAR = 970 * MiB;
constexpr int MISC_OFF = 147456 - 16 - 32;
struct Args { const float* in[17]; float* out; unsigned char* ws; };

__global__ void __launch_bounds__(NTHREADS) fwd_megakernel(Args a) {
    extern __shared__ __attribute__((aligned(16))) unsigned char lds_raw[];
    cg::grid_group grid = cg::this_grid();
    LAS unsigned char* lds = (LAS unsigned char*)lds_raw;
#define tid ((int)threadIdx.x)
#define lane ((int)threadIdx.x & 63)
#define wave (__builtin_amdgcn_readfirstlane((int)threadIdx.x >> 6))
#define G ((int)gridDim.x)
#define bx ((int)blockIdx.x)
#define gw (bx * NWAVES + wave)
#define NGW (G * NWAVES)
#define xin (a.in[0])
#define mem (a.in[1])
#define g_pre_mix (a.in[2])
#define g_post_mix (a.in[3])
#define g_pre_ffn (a.in[4])
#define g_post_ffn (a.in[5])
#define g_mem (a.in[6])
#define w_in (a.in[7])
#define w_mem_kv (a.in[8])
#define w_br_sb (a.in[9])
#define w_br_dil (a.in[10])
#define w_br_mem (a.in[11])
#define w_gate (a.in[12])
#define b_gate (a.in[13])
#define w_o (a.in[14])
#define w_ffn_in (a.in[15])
#define w_ffn_out (a.in[16])
#define XN ((bf16*)a.out)
#define WIN ((bf16*)(a.ws + OFF_WIN))
#define WCAT ((bf16*)(a.ws + OFF_WGATE))
#define WSB ((bf16*)(a.ws + OFF_WSB))
#define WDIL ((bf16*)(a.ws + OFF_WDIL))
#define WMEM ((bf16*)(a.ws + OFF_WMEM))
#define WO ((bf16*)(a.ws + OFF_WO))
#define WFI ((bf16*)(a.ws + OFF_WFI))
#define WFO ((bf16*)(a.ws + OFF_WFO))
#define WKV ((bf16*)(a.ws + OFF_WKV))
#define MEMN ((bf16*)(a.ws + OFF_MEMN))
#define KVM ((bf16*)(a.ws + OFF_KVM))
#define ROPE ((float*)(a.ws + OFF_ROPE))
#define PROJ ((bf16*)(a.ws + OFF_PROJ))
#define GS ((bf16*)(a.ws + OFF_GS))
#define MERGED ((bf16*)(a.ws + OFF_MERGED))
#define XN2 ((bf16*)(a.ws + OFF_XN2))
#define FO ((bf16*)(a.ws + OFF_FO))
#define OBG ((bf16*)(a.ws + OFF_OBG))
#define OA ((bf16*)(a.ws + OFF_OA))
#define OB (OA + 512)
#define OC (OA + 768)
#define MIX ((bf16*)(a.ws + OFF_MIX))
#define FB ((bf16*)(a.ws + OFF_F))
#define LSE ((float*)(a.ws + OFF_LSE))
    volatile LAS unsigned* MISC = (volatile LAS unsigned*)(lds + MISC_OFF);
    if (tid < 2) MISC[8 + tid] = 0u;
    unsigned* barw = (unsigned*)(a.ws + OFF_BAR);
    if (bx == 0) for (int i = tid; i < XCD_BAR_WORDS; i += NTHREADS) barw[i] = 0u;
    __syncthreads();

    {
        LAS float* scr = (LAS float*)(lds + wave * 16384);
        constexpr int I_IN = 16 * (DIN / 32), I_G = 16 * (3072 / 32), I_SB = 8 * 32, I_DIL = 4 * 32, I_MEM = 8 * 32, I_O = 16 * 32, I_FI = 16 * (5632 / 32), I_FO = 44 * 32, I_KV = 16 * 32;
        constexpr int NITEMS = I_IN + I_G + I_SB + I_DIL + I_MEM + I_O + I_FI + I_FO + I_KV;
        for (int it = gw; it < NITEMS; it += NGW) {
            int r = it;
            if (r < I_IN) { transpose_item<1>(w_in, 1024, DIN, WIN, 1024, 0, scr, r, lane); continue; } r -= I_IN;
            if (r < I_G) { transpose_item<3>(w_gate, 1024, 3072, WCAT, 4352, 0, scr, r, lane); continue; } r -= I_G;
            if (r < I_SB) { transpose_item<0>(w_br_sb, 512, 1024, WCAT, 4352, 3072, scr, r, lane); continue; } r -= I_SB;
            if (r < I_DIL) { transpose_item<0>(w_br_dil, 256, 1024, WCAT, 4352, 3584, scr, r, lane); continue; } r -= I_DIL;
            if (r < I_MEM) { transpose_item<0>(w_br_mem, 512, 1024, WCAT, 4352, 3840, scr, r, lane); continue; } r -= I_MEM;
            if (r < I_O) { transpose_item<0>(w_o, 1024, 1024, WO, 1024, 0, scr, r, lane); continue; } r -= I_O;
            if (r < I_FI) { transpose_item<2>(w_ffn_in, 1024, 5632, WFI, 1024, 0, scr, r, lane); continue; } r -= I_FI;
            if (r < I_FO) { transpose_item<0>(w_ffn_out, DFF, 1024, WFO, DFF, 0, scr, r, lane); continue; } r -= I_FO;
            transpose_item<0>(w_mem_kv, 1024, 1024, WKV, 1024, 0, scr, r, lane);
        }
        for (int m = gw; m < T; m += 2 * NGW) { const int mb = (m + NGW < T) ? m + NGW : m; rms_row2_to_bf16(xin + (size_t)m * D, xin + (size_t)mb * D, g_pre_mix, XN + (size_t)m * XNP, XN + (size_t)mb * XNP, lane); }
        for (int m = gw; m < MEMT; m += 2 * NGW) { const int mb = (m + NGW < MEMT) ? m + NGW : m; rms_row2_to_bf16(mem + (size_t)m * D, mem + (size_t)mb * D, g_mem, MEMN + (size_t)m * D, MEMN + (size_t)mb * D, lane); }
        for (int i = bx * NTHREADS + tid; i < SEQ * 32; i += G * NTHREADS) { const int pos = i >> 5, j = i & 31;
            const float inv_freq = exp2f(-(float)j * (13.287712379549449f / 32.0f));
            const float ang = (float)pos * inv_freq;
            double t = (double)ang * 0.15915494309189535; t -= rint(t);
            const float tf = (float)t;
            ROPE[2 * i] = __builtin_amdgcn_cosf(tf); ROPE[2 * i + 1] = __builtin_amdgcn_sinf(tf); }
    }
    grid.sync();
    (void)xcd_barrier_post(barw, MISC + 8);
#define GRID_BAR() do { XcdBarrier xb_; xb_.bar = (unsigned*)(a.ws + OFF_BAR); xb_.x = xb_xcc_id(); xb_.st = (volatile LAS unsigned*)(lds + MISC_OFF) + 8; xcd_barrier(xb_); } while (0)

    {
        pg8::Gemm g{XN, WIN, T, DIN, D, XNP, D}; pg8::StaticOrder S; S.init(T, DIN, G, bx);
        pg8::EpiProj E{PROJ, ROPE};
        pg8::gemm_phase<pg8::EpiProj, pg8::StaticOrder, true, true>(lds, g, S, E);
    }
    {
        pg8::Gemm g{MEMN, WKV, MEMT, 1024, D}; pg8::StaticOrder S; S.init(MEMT, 1024, G, bx);
        pg8::EpiPlain E{KVM, 1024};
        pg8::gemm_phase<pg8::EpiPlain, pg8::StaticOrder, true, true>(lds, g, S, E);
    }
    GRID_BAR();

    LAS unsigned char* vimg = lds + wave * 16384;
    {
        for (int c = bx; c < NB_ * 8; c += G) {
            const int b = c >> 3, hh = (c >> 1) & 3, h2 = c & 1;
#define BAND_STEP(ST, G_, SH_, RHO_, NB0_, IMG_, KR0_, NROWS_) \
                const int G_ = (ST) >> 2, s4_##G_ = (ST) & 3, SH_ = 2 * G_, L_##G_ = SEQ >> SH_; \
                const int RHO_ = (G_ == 0) ? 0 : (G_ == 1 ? s4_##G_ : 4 * s4_##G_);                         \
                const int NB0_ = (G_ == 0) ? 1024 * h2 + 256 * s4_##G_ : (G_ == 1 ? 256 * h2 : 0);     \
                const unsigned IMG_ = (unsigned)(3 * pg8::SZ64 + (size_t)(3 * G_) * pg8::SZ32 + ((size_t)(b * 4 + hh) * 2048 + RHO_ * L_##G_) * 64);     \
                const int KR0_ = (G_ < 2) ? NB0_ - 128 : 0, NROWS_ = (G_ < 2) ? 384 : 512;
            att::u32x4 kreg[8], vreg[8];
            { BAND_STEP(0, g0_, sh0_, rho0_, nb00_, img0_, kr00_, nrows0_) (void)sh0_; (void)rho0_; (void)nb00_;
              att::img_load(PROJ, img0_ + (unsigned)pg8::SZ32, img0_ + 2u * (unsigned)pg8::SZ32, kr00_, nrows0_, kreg, vreg, tid); }
            for (int st = 0; st < 12; ++st) {
                BAND_STEP(st, g, sh, rho, nb0, img, kr0, nrows) (void)kr0;
                __syncthreads();
                att::img_store(lds, lds + 512 * att::BP, nrows, kreg, vreg, tid);
                __syncthreads();
                if (st < 11) { BAND_STEP(st + 1, gn, shn, rhon, nb0n, imgn, kr0n, nrowsn) (void)shn; (void)rhon; (void)nb0n;
                    att::img_load(PROJ, imgn + (unsigned)pg8::SZ32, imgn + 2u * (unsigned)pg8::SZ32, kr0n, nrowsn, kreg, vreg, tid); }
                int n0, qrow, row0, kn0, ntiles, rho_w;
                if (g < 2) { n0 = nb0 + 32 * wave; qrow = n0; row0 = 32 * wave; kn0 = nb0 - 128 + 32 * wave; ntiles = 5; rho_w = rho; }
                else { const int res = wave >> 1, qt = wave & 1; n0 = 64 * h2 + 32 * qt; qrow = 128 * res + n0; row0 = 128 * res; kn0 = 0; ntiles = (n0 >> 5) + 1; rho_w = rho + res; }
                bf16* ob = OBG + (size_t)g * T * 256 + ((size_t)b * SEQ + rho_w) * 256 + hh * 64;
                float* ls = LSE + (size_t)g * T * 4 + ((size_t)b * SEQ + rho_w) * 4 + hh;
                att::band_item_lds(PROJ, img, qrow, n0, row0, kn0, ntiles, ob, (long)(256 << sh), ls, (long)(4 << sh), lds, lds + 512 * att::BP, lane);
            }
#undef BAND_STEP
            asm volatile("s_waitcnt vmcnt(0)" ::: "memory"); __syncthreads();
            for (int i = tid; i < 1024 * 8; i += NTHREADS) {
                const int ch = i & 7; const size_t t = (size_t)b * SEQ + 1024 * h2 + (i >> 3);
                const float l0 = LSE[t * 4 + hh], l1 = LSE[(size_t)T * 4 + t * 4 + hh], l2 = LSE[(size_t)2 * T * 4 + t * 4 + hh];
                const float mx = fmaxf(l0, fmaxf(l1, l2));
                float a0 = __expf(l0 - mx), a1 = __expf(l1 - mx), a2 = __expf(l2 - mx); const float is = 1.0f / (a0 + a1 + a2); a0 *= is; a1 *= is; a2 *= is;
                const size_t off = t * 256 + hh * 64 + ch * 8;
                const v4u p0 = *(const v4u*)(OBG + off), p1 = *(const v4u*)(OBG + (size_t)T * 256 + off), p2 = *(const v4u*)(OBG + (size_t)2 * T * 256 + off);
                v4u o;
                o.x = pk2(a0 * bfl(p0.x) + a1 * bfl(p1.x) + a2 * bfl(p2.x), a0 * bfh(p0.x) + a1 * bfh(p1.x) + a2 * bfh(p2.x));
                o.y = pk2(a0 * bfl(p0.y) + a1 * bfl(p1.y) + a2 * bfl(p2.y), a0 * bfh(p0.y) + a1 * bfh(p1.y) + a2 * bfh(p2.y));
                o.z = pk2(a0 * bfl(p0.z) + a1 * bfl(p1.z) + a2 * bfl(p2.z), a0 * bfh(p0.z) + a1 * bfh(p1.z) + a2 * bfh(p2.z));
                o.w = pk2(a0 * bfl(p0.w) + a1 * bfl(p1.w) + a2 * bfl(p2.w), a0 * bfh(p0.w) + a1 * bfh(p1.w) + a2 * bfh(p2.w));
                *(v4u*)(OB + t * OP + hh * 64 + ch * 8) = o;
            }
        }
        for (int c = bx; c < NB_ * 8; c += G) {
            const int b = c >> 3, hh = c & 7;
            const unsigned qb = (unsigned)((size_t)(b * 8 + hh) * 2048 * 64);
            bf16* ob = OA + (size_t)b * SEQ * OP + hh * 64;
            att::u32x4 kreg[8], vreg[8];
            att::img_load(PROJ, qb + (unsigned)pg8::SZ64, qb + 2u * (unsigned)pg8::SZ64, 0, 256, kreg, vreg, tid);
            for (int st = 0; st < 8; ++st) {
                const int n0 = 256 * st + 32 * wave, r_ = lane & 31, h_ = lane >> 5;
                att::bf16x8 qf[4]; att::f32x16 o[2]; float R = 1.0f; bool done = false;
#pragma unroll
                for (int d0 = 0; d0 < 4; ++d0) qf[d0] = *(const att::bf16x8*)((const char*)PROJ + 2u * (qb + (unsigned)((n0 + r_) * 64 + 16 * d0 + 8 * h_)));
#pragma unroll
                for (int db = 0; db < 2; ++db)
#pragma unroll
                    for (int i = 0; i < 16; ++i) o[db][i] = 0.f;
                int top = 256 * st + 256; bool first_round = true;
                for (;;) {
                    const int base_row = top > 480 ? top - 480 : 0;
                    __syncthreads();
                    if (first_round) att::img_store(lds, lds + 480 * att::BP, top - base_row, kreg, vreg, tid);
                    else att::band_fill(PROJ, qb + (unsigned)pg8::SZ64, qb + 2u * (unsigned)pg8::SZ64, base_row, top - base_row, lds, lds + 480 * att::BP, tid);
                    __syncthreads();
                    if (first_round && st < 7) { const int topn = 256 * st + 512, basen = topn > 480 ? topn - 480 : 0;
                        att::img_load(PROJ, qb + (unsigned)pg8::SZ64, qb + 2u * (unsigned)pg8::SZ64, basen, topn - basen, kreg, vreg, tid); }
                    first_round = false;
                    if (!done) { const int kb_hi = n0 < top - 32 ? n0 : top - 32;
                        done = att::stick_round_lds(qf, o, R, n0, kb_hi, base_row, lds, lds + 480 * att::BP, lane) || (base_row == 0); }
                    if (!__syncthreads_or(done ? 0 : 1)) break;
                    top = base_row;
                }
                bf16* orow = ob + (size_t)(n0 + r_) * OP;
#pragma unroll
                for (int db = 0; db < 2; ++db) att::store_o32(orow + 32 * db, o[db], 1.0f, h_);
            }
        }
        for (int c = bx; c < NB_ * 8; c += G) {
            const int b = c >> 3, hh = (c >> 1) & 3, half = c & 1;
            const bf16* qb = PROJ + 3 * pg8::SZ64 + 9 * pg8::SZ32 + (size_t)(b * 4 + hh) * 2048 * 128;
            const bf16* kb = KVM + (size_t)b * 256 * 1024 + hh * 128;
            bf16* ob = OC + (size_t)b * SEQ * OP + hh * 128;
            __syncthreads();
            att::xattn_fill(kb, kb + 512, lds, lds + 256 * att::XP, tid);
            __syncthreads();
            att::bf16x8 xq[8], xqn[8];
            att::xattn_q_load(qb, (32 * half + wave) * 32, xq, lane);
            for (int k = 0; k < 4; ++k) { const int n0 = (32 * half + wave + 8 * k) * 32;
                if (k < 3) att::xattn_q_load(qb, n0 + 256, xqn, lane);
                att::xattn_item_lds(xq, n0, 0.08838834764831845f, ob, OP, lds, lds + 256 * att::XP, lane);
#pragma unroll
                for (int d0 = 0; d0 < 8; ++d0) xq[d0] = xqn[d0]; }
        }
        __syncthreads();
    }
    GRID_BAR();

    {
        pg8::Gemm g{XN, WCAT, T, 1024, D, XNP, 4352}; pg8::P3Order S; S.S.init(T, 1024, G, bx); S.xnp = XN; S.oabc = OA; S.wcat = WCAT;
        pg8::EpiP3 E{GS, MERGED, b_gate};
        pg8::gemm_phase<pg8::EpiP3, pg8::P3Order, true, true, true>(lds, g, S, E);
    }
    GRID_BAR();

    {
        pg8::Gemm g{MERGED, WO, T, 1024, D}; pg8::StaticOrder S; S.init(T, 1024, G, bx);
        pg8::EpiPlain E{MIX, 1024};
        pg8::gemm_phase<pg8::EpiPlain, pg8::StaticOrder, true, true>(lds, g, S, E);
    }
    GRID_BAR();

    {
        for (int m0 = gw; m0 < T; m0 += 2 * NGW) {
            f32x4 v[2][4], xx[2][4]; float s[2] = {0.f, 0.f}, s2[2] = {0.f, 0.f};
#pragma unroll
            for (int u = 0; u < 2; ++u) { const int m = (m0 + u * NGW < T) ? m0 + u * NGW : m0;     const v2u* mr = (const v2u*)(MIX + (size_t)m * D) + lane; const f32x4* xr = (const f32x4*)(xin + (size_t)m * D) + lane;
#pragma unroll
                for (int j = 0; j < 4; ++j) { const v2u w = __builtin_nontemporal_load(mr + 64 * j); xx[u][j] = __builtin_nontemporal_load(xr + 64 * j); v[u][j] = (f32x4){bfl(w.x), bfh(w.x), bfl(w.y), bfh(w.y)}; } }
#pragma unroll
            for (int u = 0; u < 2; ++u)
#pragma unroll
                for (int j = 0; j < 4; ++j) s[u] += (v[u][j].x * v[u][j].x + v[u][j].y * v[u][j].y) + (v[u][j].z * v[u][j].z + v[u][j].w * v[u][j].w);
#pragma unroll
            for (int u = 0; u < 2; ++u) { const float rstd = 1.0f / sqrtf(wave_sum(s[u]) * (1.0f / D) + EPS);
#pragma unroll
                for (int j = 0; j < 4; ++j) { const f32x4 gg = ((const f32x4*)g_post_mix + lane)[64 * j]; v[u][j] = xx[u][j] + v[u][j] * rstd * gg; s2[u] += (v[u][j].x * v[u][j].x + v[u][j].y * v[u][j].y) + (v[u][j].z * v[u][j].z + v[u][j].w * v[u][j].w); } }
#pragma unroll
            for (int u = 0; u < 2; ++u) { const float rstd2 = 1.0f / sqrtf(wave_sum(s2[u]) * (1.0f / D) + EPS); unsigned long long* o8 = (unsigned long long*)(XN2 + (size_t)((m0 + u * NGW < T) ? m0 + u * NGW : m0) * D) + lane;
#pragma unroll
                for (int j = 0; j < 4; ++j) { const f32x4 gg = ((const f32x4*)g_pre_ffn + lane)[64 * j];
                    o8[64 * j] = (unsigned long long)pk2(v[u][j].x * rstd2 * gg.x, v[u][j].y * rstd2 * gg.y) | ((unsigned long long)pk2(v[u][j].z * rstd2 * gg.z, v[u][j].w * rstd2 * gg.w) << 32); } }
        }
    }
    GRID_BAR();

    {
        pg8::Gemm g{XN2, WFI, T, 2 * DFF, D}; pg8::StaticOrder S; S.init(T, 2 * DFF, G, bx);
        pg8::EpiSwiglu E{FB};
        pg8::gemm_phase<pg8::EpiSwiglu, pg8::StaticOrder, true, true>(lds, g, S, E);
    }
    GRID_BAR();

    {
        pg8::Gemm g{FB, WFO, T, 1024, DFF}; pg8::StaticOrder S; S.init(T, 1024, G, bx);
        pg8::EpiPlain E{FO, 1024};
        pg8::gemm_phase<pg8::EpiPlain, pg8::StaticOrder, true, true>(lds, g, S, E);
    }
    GRID_BAR();

    {
        for (int m0 = gw; m0 < T; m0 += 2 * NGW) {
            f32x4 v[2][4], f[2][4], xx[2][4]; float s[2] = {0.f, 0.f}, s3[2] = {0.f, 0.f};
#pragma unroll
            for (int u = 0; u < 2; ++u) { const int m = (m0 + u * NGW < T) ? m0 + u * NGW : m0;     const v2u* mr = (const v2u*)(MIX + (size_t)m * D) + lane; const v2u* fr_ = (const v2u*)(FO + (size_t)m * D) + lane; const f32x4* xr = (const f32x4*)(xin + (size_t)m * D) + lane;
#pragma unroll
                for (int j = 0; j < 4; ++j) { const v2u w = __builtin_nontemporal_load(mr + 64 * j), q = __builtin_nontemporal_load(fr_ + 64 * j); xx[u][j] = __builtin_nontemporal_load(xr + 64 * j);
                    v[u][j] = (f32x4){bfl(w.x), bfh(w.x), bfl(w.y), bfh(w.y)}; f[u][j] = (f32x4){bfl(q.x), bfh(q.x), bfl(q.y), bfh(q.y)}; } }
#pragma unroll
            for (int u = 0; u < 2; ++u)
#pragma unroll
                for (int j = 0; j < 4; ++j) { s[u] += (v[u][j].x * v[u][j].x + v[u][j].y * v[u][j].y) + (v[u][j].z * v[u][j].z + v[u][j].w * v[u][j].w); s3[u] += (f[u][j].x * f[u][j].x + f[u][j].y * f[u][j].y) + (f[u][j].z * f[u][j].z + f[u][j].w * f[u][j].w); }
#pragma unroll
            for (int u = 0; u < 2; ++u) { const float rstd = 1.0f / sqrtf(wave_sum(s[u]) * (1.0f / D) + EPS), rstd3 = 1.0f / sqrtf(wave_sum(s3[u]) * (1.0f / D) + EPS);
                f32x4* xo = (f32x4*)(a.out + (size_t)((m0 + u * NGW < T) ? m0 + u * NGW : m0) * D) + lane;
#pragma unroll
                for (int j = 0; j < 4; ++j) { const f32x4 g1 = ((const f32x4*)g_post_mix + lane)[64 * j], g3 = ((const f32x4*)g_post_ffn + lane)[64 * j];
                    xo[64 * j] = (xx[u][j] + v[u][j] * rstd * g1) + f[u][j] * rstd3 * g3; } }
        }
    }
}

extern "C" void kernel_launch(void* const* d_in, const int* in_sizes, int n_in, void* d_out, int out_size, void* d_ws, size_t ws_size, hipStream_t stream) {
    static int grid = 0;
    if (grid == 0) {
        if (n_in != 17 || in_sizes[0] != T * D || out_size != T * D || ws_size < 971 * MiB) { fprintf(stderr, "kernel_launch: unexpected shapes / workspace (n_in %d, in0 %d, out %d, ws %zu, need %zu)\n", n_in, n_in > 0 ? in_sizes[0] : -1, out_size, ws_size, (size_t)WS_END); grid = -1; return; }
        int dev = 0, cus = 0, per_cu = 0;
        hipGetDevice(&dev); hipDeviceGetAttribute(&cus, hipDeviceAttributeMultiprocessorCount, dev);
        if (hipFuncSetAttribute((const void*)fwd_megakernel, hipFuncAttributeMaxDynamicSharedMemorySize, LDS_BYTES) != hipSuccess) { fprintf(stderr, "kernel_launch: hipFuncSetAttribute failed\n"); grid = -1; return; }
        if (hipOccupancyMaxActiveBlocksPerMultiprocessor(&per_cu, (const void*)fwd_megakernel, NTHREADS, LDS_BYTES) != hipSuccess || per_cu < 1) { fprintf(stderr, "kernel_launch: occupancy query says %d blocks per CU\n", per_cu); per_cu = 1; }
        (void)hipGetLastError();
        grid = cus * 1;
    }
    if (grid < 0) return;
    Args a{};
    for (int i = 0; i < 17; ++i) a.in[i] = (const float*)d_in[i];
    a.out = (float*)d_out; a.ws = (unsigned char*)d_ws;
    void* args[] = {&a};
    hipError_t e = hipLaunchCooperativeKernel((const void*)fwd_megakernel, dim3(grid), dim3(NTHREADS), args, LDS_BYTES, stream);
    if (e != hipSuccess) fprintf(stderr, "kernel_launch: cooperative launch failed: %s (grid %d)\n", hipGetErrorString(e), grid);
}
```

```cpp
#include <hip/hip_runtime.h>
#include <hip/hip_cooperative_groups.h>
#include <cstdio>
#include <cstdint>
namespace cg = cooperative_groups;
namespace pg8 {
#define PG8_LAS __attribute__((address_space(3)))
typedef unsigned short bf16_t;
typedef short bf16x8 __attribute__((ext_vector_type(8)));
typedef float f32x4 __attribute__((ext_vector_type(4)));
typedef unsigned u32x4 __attribute__((ext_vector_type(4)));
constexpr int BM = 256, BK = 64, HALF = 128, HTB = HALF * BK * 2  , STAGE_BYTES = 8 * HTB, NXCD = 8, WGM = 8;

__host__ __device__ __forceinline__ int lds_byte(int r, int c) { const int st = (r >> 4) * 2 + (c >> 5), rr = r & 15, cc = c & 31, ob = rr * 64 + cc * 2; return st * 1024 + (ob ^ (((ob >> 9) & 1) << 5)); }
__host__ __device__ __forceinline__ void stage_rc(int b, int& R, int& C) { const int st = b / 1024, sb = b % 1024, swz = sb ^ (((sb >> 9) & 1) << 5); R = (st >> 1) * 16 + swz / 64; C = (st & 1) * 32 + (swz % 64) / 2; }
__host__ __device__ __forceinline__ int perm32(int rho) { const int n = rho >> 4, i = rho & 15; return 8 * (i >> 2) + 4 * n + (i & 3); }

struct Unit { int pm, pn; const bf16_t* A = nullptr; const bf16_t* Bt = nullptr; int nt = 0, step = 0; };
struct Gemm { const bf16_t* A; const bf16_t* Bt; int M, N, K; int lda = 0, ldb = 0; };

struct StaticOrder {
    int nM, nN, nwg, G, c;
    __host__ __device__ void init(int M, int N, int G_, int c_) { nM = M / BM; nN = N / BM; nwg = nM * nN; G = G_; c = c_; }
    __host__ __device__ bool next(int i, Unit& u) const {
        const long L = (long)i * G + c; if (L >= nwg) return false;
        int wgid = (int)L; { const int q = nwg / NXCD, r = nwg % NXCD, xcd = wgid % NXCD, off = wgid / NXCD; wgid = (xcd < r ? xcd * (q + 1) : r * (q + 1) + (xcd - r) * q) + off; }
        const int nig = WGM * nN, gid = wgid / nig, fm = gid * WGM, gsz = (nM - fm) < WGM ? (nM - fm) : WGM;
        u.pm = fm + ((wgid % nig) % gsz); u.pn = (wgid % nig) / gsz; return true;
    }
    __device__ __forceinline__ void a_ready(const Unit&) const {}
    __device__ __forceinline__ void done(const Unit&) const {}
};

typedef float f32x2 __attribute__((ext_vector_type(2)));
typedef __bf16 pg8_bf16x2 __attribute__((ext_vector_type(2)));
__device__ __forceinline__ unsigned cvt_pk_bf16(float lo, float hi) { f32x2 v = {lo, hi}; pg8_bf16x2 b = __builtin_convertvector(v, pg8_bf16x2); return __builtin_bit_cast(unsigned, b); }
typedef unsigned u32x2 __attribute__((ext_vector_type(2)));
__device__ __forceinline__ float bf_lo(unsigned w) { return __uint_as_float(w << 16); }
__device__ __forceinline__ float bf_hi(unsigned w) { return __uint_as_float(w & 0xffff0000u); }
__device__ __forceinline__ float sigmoidf_fast(float v) { return __builtin_amdgcn_rcpf(1.0f + __builtin_amdgcn_exp2f(-1.4426950408889634f * v)); }
__device__ __forceinline__ u32x4 pack8(const f32x4 v0, const f32x4 v1) { u32x4 w; w.x = cvt_pk_bf16(v0[0], v0[1]); w.y = cvt_pk_bf16(v0[2], v0[3]); w.z = cvt_pk_bf16(v1[0], v1[1]); w.w = cvt_pk_bf16(v1[2], v1[3]); return w; }

__device__ __forceinline__ u32x4 ld16_agent(const bf16_t* p) { const unsigned long long* q = (const unsigned long long*)p;
    const unsigned long long a = __hip_atomic_load(q, __ATOMIC_RELAXED, __HIP_MEMORY_SCOPE_AGENT), b = __hip_atomic_load(q + 1, __ATOMIC_RELAXED, __HIP_MEMORY_SCOPE_AGENT);
    u32x4 r; r.x = (unsigned)a; r.y = (unsigned)(a >> 32); r.z = (unsigned)b; r.w = (unsigned)(b >> 32); return r; }
struct EpiPlain {
    static constexpr bool PERM = true, AFTER_DRAIN = false;
    bf16_t* O; int ldc;
    __device__ __forceinline__ void operator()(const f32x4 (&acc)[2][2][4][2], const Unit& u, int wr, int wc, int fr, int fq) const {
        const int row0 = u.pm * BM + wr * 64 + fr, col0 = u.pn * BM + wc * 32 + 8 * fq;
#pragma unroll
        for (int ai = 0; ai < 2; ++ai)
#pragma unroll
            for (int m = 0; m < 4; ++m) { bf16_t* rowp = O + (size_t)(row0 + ai * HALF + m * 16) * ldc + col0;
#pragma unroll
                for (int bj = 0; bj < 2; ++bj) *(u32x4*)(rowp + bj * HALF) = pack8(acc[ai][bj][m][0], acc[ai][bj][m][1]); }
    }
};
constexpr size_t SZ64 = 33554432ull, SZ32 = 16777216ull;
__device__ __forceinline__ size_t proj_off(int pn, int row, int cl) {
    const int b = row >> 11, s = row & 2047;
    if (pn < 6) { const int kind = pn >> 1, c = (pn & 1) * 256 + cl, hh = c >> 6, dd = c & 63; return (size_t)kind * SZ64 + ((size_t)(b * 8 + hh) * 2048 + s) * 64 + dd; }
    if (pn < 15) { const int gk = pn - 6, g = gk / 3, hh = cl >> 6, dd = cl & 63, sh = 2 * g, rho = s & ((1 << sh) - 1), n = s >> sh, L = 2048 >> sh;
        return 3 * SZ64 + (size_t)gk * SZ32 + ((size_t)(b * 4 + hh) * 2048 + rho * L + n) * 64 + dd; }
    { const int c = (pn - 15) * 256 + cl, hh = c >> 7, dd = c & 127; return 3 * SZ64 + 9 * SZ32 + ((size_t)(b * 4 + hh) * 2048 + s) * 128 + dd; }
}
struct EpiProj {
    static constexpr bool PERM = true, AFTER_DRAIN = false;
    bf16_t* O; const float* rope;
    __device__ __forceinline__ void operator()(const f32x4 (&acc)[2][2][4][2], const Unit& u, int wr, int wc, int fr, int fq) const {
        const int pn = u.pn;
        const int dg = pn - 6;
        const bool dil = (dg >= 0 && dg < 9);
        const bool is_rope = dil && (dg % 3) != 2;
        const float sc = (pn < 2 || (dil && (dg % 3) == 0)) ? 0.125f : 1.0f;
        const int row0 = u.pm * BM + wr * 64 + fr, cl0 = wc * 32 + 8 * fq;
#pragma unroll
        for (int ai = 0; ai < 2; ++ai)
#pragma unroll
            for (int m = 0; m < 4; ++m) { const int row = row0 + ai * HALF + m * 16; const int pos = row & 2047;
                const size_t po = proj_off(pn, row, cl0);
#pragma unroll
                for (int bj = 0; bj < 2; ++bj) { f32x4 v0 = acc[ai][bj][m][0], v1 = acc[ai][bj][m][1];
                    if (is_rope) { const int jb = ((cl0 + bj * HALF) & 63) >> 1;
                        const f32x4 c0 = *(const f32x4*)(rope + (size_t)(pos * 32 + jb) * 2), c1 = *(const f32x4*)(rope + (size_t)(pos * 32 + jb + 2) * 2);
                        f32x4 t0, t1;
                        t0[0] = v0[0] * c0[0] - v0[1] * c0[1]; t0[1] = v0[1] * c0[0] + v0[0] * c0[1]; t0[2] = v0[2] * c0[2] - v0[3] * c0[3]; t0[3] = v0[3] * c0[2] + v0[2] * c0[3];
                        t1[0] = v1[0] * c1[0] - v1[1] * c1[1]; t1[1] = v1[1] * c1[0] + v1[0] * c1[1]; t1[2] = v1[2] * c1[2] - v1[3] * c1[3]; t1[3] = v1[3] * c1[2] + v1[2] * c1[3];
                        v0 = t0; v1 = t1; }
                    v0 = v0 * sc; v1 = v1 * sc;
                    *(u32x4*)(O + po + (size_t)bj * 262144) = pack8(v0, v1); } }
    }
};
struct EpiGate {
    static constexpr bool PERM = true, AFTER_DRAIN = false;
    bf16_t* O; const float* bias;
    __device__ __forceinline__ void operator()(const f32x4 (&acc)[2][2][4][2], const Unit& u, int wr, int wc, int fr, int fq) const {
        const int row0 = u.pm * BM + wr * 64 + fr, col0 = u.pn * BM + wc * 32 + 8 * fq;
        f32x4 bv[2][2];
#pragma unroll
        for (int bj = 0; bj < 2; ++bj)
#pragma unroll
            for (int n = 0; n < 2; ++n) bv[bj][n] = *(const f32x4*)(bias + col0 + bj * HALF + 4 * n);
#pragma unroll
        for (int ai = 0; ai < 2; ++ai)
#pragma unroll
            for (int m = 0; m < 4; ++m) { bf16_t* rowp = O + (size_t)(row0 + ai * HALF + m * 16) * 1024 + col0;
#pragma unroll
                for (int bj = 0; bj < 2; ++bj) { f32x4 v0 = acc[ai][bj][m][0] + bv[bj][0], v1 = acc[ai][bj][m][1] + bv[bj][1];
#pragma unroll
                    for (int e = 0; e < 4; ++e) { v0[e] = sigmoidf_fast(v0[e]); v1[e] = sigmoidf_fast(v1[e]); }
                    *(u32x4*)(rowp + bj * HALF) = pack8(v0, v1); } }
    }
};
template <bool FIRST> struct EpiBranch {
    static constexpr bool PERM = true, AFTER_DRAIN = false;
    bf16_t* MG; const bf16_t* GS;
    __device__ __forceinline__ void operator()(const f32x4 (&acc)[2][2][4][2], const Unit& u, int wr, int wc, int fr, int fq) const {
        const int row0 = u.pm * BM + wr * 64 + fr, col0 = u.pn * BM + wc * 32 + 8 * fq;
#pragma unroll
        for (int ai = 0; ai < 2; ++ai)
#pragma unroll
            for (int m = 0; m < 4; ++m) { const size_t off = (size_t)(row0 + ai * HALF + m * 16) * 1024 + col0;
#pragma unroll
                for (int bj = 0; bj < 2; ++bj) { const u32x4 g = ld16_agent(GS + off + bj * HALF);
                    f32x4 v0 = acc[ai][bj][m][0], v1 = acc[ai][bj][m][1];
                    v0[0] *= bf_lo(g.x); v0[1] *= bf_hi(g.x); v0[2] *= bf_lo(g.y); v0[3] *= bf_hi(g.y);
                    v1[0] *= bf_lo(g.z); v1[1] *= bf_hi(g.z); v1[2] *= bf_lo(g.w); v1[3] *= bf_hi(g.w);
                    if (!FIRST) { const u32x4 p = ld16_agent(MG + off + bj * HALF);
                        v0[0] += bf_lo(p.x); v0[1] += bf_hi(p.x); v0[2] += bf_lo(p.y); v0[3] += bf_hi(p.y);
                        v1[0] += bf_lo(p.z); v1[1] += bf_hi(p.z); v1[2] += bf_lo(p.w); v1[3] += bf_hi(p.w); }
                    *(u32x4*)(MG + off + bj * HALF) = pack8(v0, v1); } }
    }
};
struct EpiSwiglu {
    static constexpr bool PERM = true, AFTER_DRAIN = false;
    bf16_t* O;
    __device__ __forceinline__ void operator()(const f32x4 (&acc)[2][2][4][2], const Unit& u, int wr, int wc, int fr, int fq) const {
        const int row0 = u.pm * BM + wr * 64 + fr, col0 = u.pn * HALF + wc * 32 + 8 * fq;
#pragma unroll
        for (int ai = 0; ai < 2; ++ai)
#pragma unroll
            for (int m = 0; m < 4; ++m) { bf16_t* rowp = O + (size_t)(row0 + ai * HALF + m * 16) * 2816 + col0;
                f32x4 v0, v1;
#pragma unroll
                for (int e = 0; e < 4; ++e) { const float g0 = acc[ai][0][m][0][e], g1 = acc[ai][0][m][1][e];
                    v0[e] = g0 * sigmoidf_fast(g0) * acc[ai][1][m][0][e]; v1[e] = g1 * sigmoidf_fast(g1) * acc[ai][1][m][1][e]; }
                *(u32x4*)rowp = pack8(v0, v1); }
    }
};

struct P3Order {
    StaticOrder S; const bf16_t* xnp; const bf16_t* oabc; const bf16_t* wcat;
    __device__ __forceinline__ bool next(int i, Unit& u) const {
        if (!S.next(i / 6, u)) return false;
        const int st = i % 6, br = st >> 1; u.step = st;
        if (st & 1) { u.A = xnp; u.Bt = wcat + br * 1024; u.nt = 16; }
        else { const int co = (br == 0) ? 0 : (br == 1 ? 512 : 768); u.A = oabc + co; u.Bt = wcat + 3072 + co; u.nt = (br == 1) ? 4 : 8; }
        return true;
    }
    __device__ __forceinline__ void a_ready(const Unit&) const {}
    __device__ __forceinline__ void done(const Unit&) const {}
};
struct EpiP3 {
    static constexpr bool PERM = true, AFTER_DRAIN = false;
    bf16_t* YS; bf16_t* MG; const float* bias;
    __device__ __forceinline__ void operator()(const f32x4 (&acc)[2][2][4][2], const Unit& u, int wr, int wc, int fr, int fq) const {
        const int row0 = u.pm * BM + wr * 64 + fr, col0 = u.pn * BM + wc * 32 + 8 * fq;
        if ((u.step & 1) == 0) {
#pragma unroll
            for (int ai = 0; ai < 2; ++ai)
#pragma unroll
                for (int m = 0; m < 4; ++m) { bf16_t* rowp = YS + (size_t)(row0 + ai * HALF + m * 16) * 1024 + col0;
#pragma unroll
                    for (int bj = 0; bj < 2; ++bj) *(u32x4*)(rowp + bj * HALF) = pack8(acc[ai][bj][m][0], acc[ai][bj][m][1]); }
        } else {
            const int br = u.step >> 1; const bool first = (br == 0);
            f32x4 bv[2][2];
#pragma unroll
            for (int bj = 0; bj < 2; ++bj)
#pragma unroll
                for (int n = 0; n < 2; ++n) bv[bj][n] = *(const f32x4*)(bias + br * 1024 + col0 + bj * HALF + 4 * n);
#pragma unroll
            for (int ai = 0; ai < 2; ++ai)
#pragma unroll
                for (int m = 0; m < 4; ++m) { const size_t off = (size_t)(row0 + ai * HALF + m * 16) * 1024 + col0;
#pragma unroll
                    for (int bj = 0; bj < 2; ++bj) { const u32x4 y = *(const u32x4*)(YS + off + bj * HALF);
                        f32x4 v0 = acc[ai][bj][m][0] + bv[bj][0], v1 = acc[ai][bj][m][1] + bv[bj][1];
#pragma unroll
                        for (int e = 0; e < 4; ++e) { v0[e] = sigmoidf_fast(v0[e]); v1[e] = sigmoidf_fast(v1[e]); }
                        v0[0] *= bf_lo(y.x); v0[1] *= bf_hi(y.x); v0[2] *= bf_lo(y.y); v0[3] *= bf_hi(y.y);
                        v1[0] *= bf_lo(y.z); v1[1] *= bf_hi(y.z); v1[2] *= bf_lo(y.w); v1[3] *= bf_hi(y.w);
                        if (!first) { const u32x4 p = *(const u32x4*)(MG + off + bj * HALF);
                            v0[0] += bf_lo(p.x); v0[1] += bf_hi(p.x); v0[2] += bf_lo(p.y); v0[3] += bf_hi(p.y);
                            v1[0] += bf_lo(p.z); v1[1] += bf_hi(p.z); v1[2] += bf_lo(p.w); v1[3] += bf_hi(p.w); }
                        *(u32x4*)(MG + off + bj * HALF) = pack8(v0, v1); } }
        }
    }
};
template <class Epi, class Sched, bool ALIGN_EPI = false, bool SP2 = false, bool MULTI = false>
__device__ __forceinline__ void gemm_phase(PG8_LAS unsigned char* lds, const Gemm g, const Sched& S, const Epi& E) {
    int tid_ = threadIdx.x; asm volatile("" : "+v"(tid_));
    const int tid = tid_, wid = __builtin_amdgcn_readfirstlane(tid >> 6), lane = tid & 63, wr = wid >> 2, wc = wid & 3, fr = lane & 15, fq = lane >> 4;
    const int lda = g.lda ? g.lda : g.K, ldb = g.ldb ? g.ldb : g.K; int nt = g.K / BK;
    unsigned voffA[2], voffB[2];
#pragma unroll
    for (int i = 0; i < 2; ++i) { int R, C; stage_rc(tid * 16 + i * 8192, R, C); const int Rb = Epi::PERM ? ((R & ~31) + perm32(R & 31)) : R;
        voffA[i] = (unsigned)(R * lda + C) * 2u; voffB[i] = (unsigned)(Rb * ldb + C) * 2u; }
    const size_t kstep = (size_t)(BK * 2);
    const size_t hstepA = (size_t)HALF * lda * 2, hstepB = (size_t)HALF * ldb * 2;
    const size_t tstepA = 2 * hstepA, tstepB = 2 * hstepB;
    const unsigned ldsw = (unsigned)wid * 1024u;
    const int aoff = lds_byte(wr * 64 + fr, fq * 8), boff = lds_byte(wc * 32 + fr, fq * 8);
#define PG8_SA(b, h) (((b) * 2 + (h)) * HTB)
#define PG8_SB(b, h) ((4 + (b) * 2 + (h)) * HTB)
#define PG8_STAGE(bufoff, gbase, voff) do { _Pragma("unroll") for (int _i = 0; _i < 2; ++_i) \
        __builtin_amdgcn_global_load_lds((const unsigned*)((const char*)(gbase) + (voff)[_i]), (PG8_LAS unsigned*)(lds + (bufoff) + ldsw + _i * 8192), 16, 0, 1); } while (0)
#define PG8_LDA(dst, b, h) do { _Pragma("unroll") for (int m = 0; m < 4; ++m) _Pragma("unroll") for (int k = 0; k < 2; ++k) dst[m][k] = *(const PG8_LAS bf16x8*)(lds + PG8_SA(b, h) + aoff + m * 2048 + k * 1024); } while (0)
#define PG8_LDB(dst, b, h) do { _Pragma("unroll") for (int n = 0; n < 2; ++n) _Pragma("unroll") for (int k = 0; k < 2; ++k) dst[n][k] = *(const PG8_LAS bf16x8*)(lds + PG8_SB(b, h) + boff + n * 2048 + k * 1024); } while (0)
#define PG8_MMA(ai, bj, At, Bt) do { __builtin_amdgcn_s_setprio(1); _Pragma("unroll") for (int m = 0; m < 4; ++m) _Pragma("unroll") for (int n = 0; n < 2; ++n) _Pragma("unroll") for (int k = 0; k < 2; ++k) \
        acc[ai][bj][m][n] = __builtin_amdgcn_mfma_f32_16x16x32_bf16(Bt[n][k], At[m][k], acc[ai][bj][m][n], 0, 0, 0); __builtin_amdgcn_s_setprio(0); } while (0)
#define PG8_WAIT_V(n) asm volatile("s_waitcnt vmcnt(" #n ")" ::: "memory")
#define PG8_WAIT_L(n) asm volatile("s_waitcnt lgkmcnt(" #n ")" ::: "memory")
#define PG8_BAR __builtin_amdgcn_s_barrier()
#define PG8_SCHED __builtin_amdgcn_sched_barrier(0)
    Unit cur, nxt; int ui = 0;
    if (!S.next(0, cur)) return;
    f32x4 acc[2][2][4][2];
#pragma unroll
    for (int a = 0; a < 2; ++a)
#pragma unroll
        for (int b = 0; b < 2; ++b)
#pragma unroll
            for (int m = 0; m < 4; ++m)
#pragma unroll
                for (int n = 0; n < 2; ++n) acc[a][b][m][n] = (f32x4){0.f, 0.f, 0.f, 0.f};
    bf16x8 At[4][2], B0[2][2], B1[2][2];
    if constexpr (MULTI) nt = cur.nt;
    const char* cA = (const char*)(MULTI ? cur.A : g.A) + (size_t)cur.pm * tstepA; const char* cB = (const char*)(MULTI ? cur.Bt : g.Bt) + (size_t)cur.pn * tstepB;
    S.a_ready(cur);
    if constexpr (SP2) {
        PG8_STAGE(PG8_SB(0, 0), cB, voffB); PG8_STAGE(PG8_SB(0, 1), cB + hstepB, voffB); PG8_STAGE(PG8_SA(0, 0), cA, voffA); PG8_STAGE(PG8_SA(0, 1), cA + hstepA, voffA);
        if (wr == 1) PG8_BAR;
        PG8_WAIT_V(2); PG8_BAR;
        PG8_STAGE(PG8_SB(1, 0), cB + kstep, voffB); PG8_STAGE(PG8_SA(1, 0), cA + kstep, voffA); PG8_STAGE(PG8_SB(1, 1), cB + hstepB + kstep, voffB);
        PG8_WAIT_V(6); PG8_BAR;
    } else {
        PG8_STAGE(PG8_SB(0, 0), cB, voffB); PG8_STAGE(PG8_SA(0, 0), cA, voffA); PG8_STAGE(PG8_SB(0, 1), cB + hstepB, voffB); PG8_STAGE(PG8_SA(0, 1), cA + hstepA, voffA);
        if (wr == 1) PG8_BAR;
        PG8_WAIT_V(4); PG8_BAR;
        PG8_STAGE(PG8_SB(1, 0), cB + kstep, voffB); PG8_STAGE(PG8_SA(1, 0), cA + kstep, voffA); PG8_STAGE(PG8_SB(1, 1), cB + hstepB + kstep, voffB);
        PG8_WAIT_V(6); PG8_BAR;
    }
    for (;;) {
        const bool has_next = S.next(ui + 1, nxt);
        const char* nA = has_next ? (const char*)(MULTI ? nxt.A : g.A) + (size_t)nxt.pm * tstepA : cA; const char* nB = has_next ? (const char*)(MULTI ? nxt.Bt : g.Bt) + (size_t)nxt.pn * tstepB : cB;
        for (int t = 0; t < nt; t += 2) {
            const bool last = (t == nt - 2);
            const char* a1 = cA + (size_t)(t + 1) * kstep;
            const char* a2 = last ? nA : cA + (size_t)(t + 2) * kstep; const char* b2 = last ? nB : cB + (size_t)(t + 2) * kstep;
            const char* a3 = a2 + kstep; const char* b3 = b2 + kstep;
            if (last && has_next) S.a_ready(nxt);
            if constexpr (SP2) {
            PG8_LDB(B0, 0, 0); PG8_LDB(B1, 0, 1); PG8_SCHED; PG8_LDA(At, 0, 0); PG8_STAGE(PG8_SA(1, 1), a1 + hstepA, voffA);
            PG8_WAIT_V(8); PG8_WAIT_L(0); PG8_BAR; PG8_MMA(0, 0, At, B0); PG8_MMA(0, 1, At, B1); PG8_BAR; PG8_SCHED;
            PG8_LDA(At, 0, 1); PG8_STAGE(PG8_SB(0, 0), b2, voffB); PG8_STAGE(PG8_SB(0, 1), b2 + hstepB, voffB); PG8_STAGE(PG8_SA(0, 0), a2, voffA);
            PG8_WAIT_V(8); PG8_WAIT_L(0); PG8_BAR; PG8_MMA(1, 0, At, B0); PG8_MMA(1, 1, At, B1); PG8_BAR; PG8_SCHED;
            PG8_LDB(B0, 1, 0); PG8_LDB(B1, 1, 1); PG8_SCHED; PG8_LDA(At, 1, 0); PG8_STAGE(PG8_SA(0, 1), a2 + hstepA, voffA);
            PG8_WAIT_V(8); PG8_WAIT_L(0); PG8_BAR; PG8_MMA(0, 0, At, B0); PG8_MMA(0, 1, At, B1); PG8_BAR; PG8_SCHED;
            PG8_LDA(At, 1, 1); PG8_STAGE(PG8_SB(1, 0), b3, voffB); PG8_STAGE(PG8_SB(1, 1), b3 + hstepB, voffB); PG8_STAGE(PG8_SA(1, 0), a3, voffA);
            PG8_WAIT_V(8); PG8_WAIT_L(0); PG8_BAR; PG8_MMA(1, 0, At, B0); PG8_MMA(1, 1, At, B1); PG8_BAR; PG8_SCHED;
            } else {
            PG8_LDB(B0, 0, 0); PG8_SCHED; PG8_LDA(At, 0, 0); PG8_STAGE(PG8_SA(1, 1), a1 + hstepA, voffA);
            PG8_WAIT_L(8); PG8_BAR; PG8_WAIT_L(0); PG8_MMA(0, 0, At, B0); PG8_BAR; PG8_SCHED;
            PG8_LDB(B1, 0, 1); PG8_STAGE(PG8_SB(0, 0), b2, voffB);
            PG8_BAR; PG8_WAIT_L(0); PG8_MMA(0, 1, At, B1); PG8_BAR;
            PG8_LDA(At, 0, 1); PG8_STAGE(PG8_SA(0, 0), a2, voffA);
            PG8_BAR; PG8_WAIT_L(0); PG8_MMA(1, 0, At, B0); PG8_BAR; PG8_SCHED;
            PG8_STAGE(PG8_SB(0, 1), b2 + hstepB, voffB);
            PG8_WAIT_V(6); PG8_BAR; PG8_MMA(1, 1, At, B1); PG8_BAR;
            PG8_LDB(B0, 1, 0); PG8_SCHED; PG8_LDA(At, 1, 0); PG8_STAGE(PG8_SA(0, 1), a2 + hstepA, voffA);
            PG8_WAIT_L(8); PG8_BAR; PG8_WAIT_L(0); PG8_MMA(0, 0, At, B0); PG8_BAR; PG8_SCHED;
            PG8_LDB(B1, 1, 1); PG8_STAGE(PG8_SB(1, 0), b3, voffB);
            PG8_BAR; PG8_WAIT_L(0); PG8_MMA(0, 1, At, B1); PG8_BAR;
            PG8_LDA(At, 1, 1); PG8_STAGE(PG8_SA(1, 0), a3, voffA);
            PG8_BAR; PG8_WAIT_L(0); PG8_MMA(1, 0, At, B0); PG8_BAR; PG8_SCHED;
            PG8_STAGE(PG8_SB(1, 1), b3 + hstepB, voffB);
            PG8_WAIT_V(6); PG8_BAR; PG8_MMA(1, 1, At, B1); PG8_BAR;
            }
        }
        if constexpr (ALIGN_EPI) { if (wr == 0) PG8_BAR; }
        if constexpr (!Epi::AFTER_DRAIN) { E(acc, cur, wr, wc, fr, fq); S.done(cur); }
        if (!has_next) break;
#pragma unroll
        for (int a = 0; a < 2; ++a)
#pragma unroll
            for (int b = 0; b < 2; ++b)
#pragma unroll
                for (int m = 0; m < 4; ++m)
#pragma unroll
                    for (int n = 0; n < 2; ++n) acc[a][b][m][n] = (f32x4){0.f, 0.f, 0.f, 0.f};
        cur = nxt; cA = nA; cB = nB; ++ui; if constexpr (MULTI) nt = cur.nt;
        if constexpr (ALIGN_EPI) { if (wr == 1) PG8_BAR; }
    }
    PG8_WAIT_V(0);
    if constexpr (!ALIGN_EPI) { if (wr == 0) PG8_BAR; }
    PG8_BAR;
    if constexpr (Epi::AFTER_DRAIN) { E.fused(acc, cur, wr, wc, fr, fq, lds, wid, lane); S.done(cur); }
#undef PG8_SA
#undef PG8_SB
#undef PG8_STAGE
#undef PG8_LDA
#undef PG8_LDB
#undef PG8_MMA
#undef PG8_WAIT_V
#undef PG8_WAIT_L
#undef PG8_BAR
#undef PG8_SCHED
}
}
namespace att {
#define LAS __attribute__((address_space(3)))
typedef unsigned short bf16_t;
typedef short bf16x8 __attribute__((ext_vector_type(8)));
typedef short s16x4 __attribute__((ext_vector_type(4)));
typedef float f32x16 __attribute__((ext_vector_type(16)));
typedef float f32x2 __attribute__((ext_vector_type(2)));
typedef __bf16 bf16x2_t __attribute__((ext_vector_type(2)));
typedef unsigned u32x4 __attribute__((ext_vector_type(4)));
typedef unsigned u32x2 __attribute__((ext_vector_type(2)));
#define MFMA32(a, b, c) __builtin_amdgcn_mfma_f32_32x32x16_bf16((a), (b), (c), 0, 0, 0)
__device__ __forceinline__ int crow(int reg, int h) { return (reg & 3) + 8 * (reg >> 2) + 4 * h; }
__device__ __forceinline__ unsigned cvtpk(float lo, float hi) { f32x2 v = {lo, hi}; bf16x2_t b = __builtin_convertvector(v, bf16x2_t); return __builtin_bit_cast(unsigned, b); }
__device__ __forceinline__ float xhalf(float v, int h) { auto rr = __builtin_amdgcn_permlane32_swap(__float_as_uint(v), __float_as_uint(v), false, false); return __uint_as_float(h ? rr[0] : rr[1]); }
__device__ __forceinline__ float xmax(float v) { auto rr = __builtin_amdgcn_permlane32_swap(__float_as_uint(v), __float_as_uint(v), false, false); return __builtin_fmaxf(__uint_as_float(rr[0]), __uint_as_float(rr[1])); }
__device__ __forceinline__ float xsum(float v) { auto rr = __builtin_amdgcn_permlane32_swap(__float_as_uint(v), __float_as_uint(v), false, false); return __uint_as_float(rr[0]) + __uint_as_float(rr[1]); }
__device__ __forceinline__ s16x4 vtr(const LAS unsigned char* p) { return __builtin_bit_cast(s16x4, __builtin_amdgcn_ds_read_tr16_b64_v4i16((LAS s16x4*)p)); }

__device__ __forceinline__ void store_o32(bf16_t* __restrict__ rowblk, const f32x16& o, float inv, int h) {
#pragma unroll
    for (int gp = 0; gp < 2; ++gp) {
        const unsigned a0 = cvtpk(o[8 * gp] * inv, o[8 * gp + 1] * inv), a1 = cvtpk(o[8 * gp + 2] * inv, o[8 * gp + 3] * inv);
        const unsigned b0 = cvtpk(o[8 * gp + 4] * inv, o[8 * gp + 5] * inv), b1 = cvtpk(o[8 * gp + 6] * inv, o[8 * gp + 7] * inv);
        auto s0 = __builtin_amdgcn_permlane32_swap(a0, b0, false, false);
        auto s1 = __builtin_amdgcn_permlane32_swap(a1, b1, false, false);
        u32x4 w; w.x = s0[0]; w.y = s1[0]; w.z = s0[1]; w.w = s1[1];
        *(u32x4*)(rowblk + 16 * gp + 8 * h) = w; }
}
enum { MODE_XATTN = 0, MODE_BAND = 1, MODE_STICK = 2 };
#define ATT_LOAD_K(KB, KTX, KF) do { const int key0_ = (KTX) * KT; \
        _Pragma("unroll") for (int hf = 0; hf < NH; ++hf) { const unsigned ko = 2u * ((KB) + (unsigned)((key0_ + 32 * hf + r) * DH + 8 * h)); \
            _Pragma("unroll") for (int d0 = 0; d0 < ND; ++d0) KF[hf][d0] = *(const bf16x8*)((const char*)base + (ko + 32u * d0)); } } while (0)
#define ATT_LOAD_V(VB, KTX, VV) do { const int key0_ = (KTX) * KT; \
        _Pragma("unroll") for (int i = 0; i < NCH; ++i) { const int c = i * 64 + lane, row = c / CPR, ch = c % CPR; const int vr = key0_ + row; \
            VV[i] = *(const u32x4*)((const char*)base + 2u * ((VB) + (unsigned)(vr * DH + ch * 8))); } } while (0)
#define ATT_LOAD_Q(QB, N0, QF) do { _Pragma("unroll") for (int d0 = 0; d0 < ND; ++d0) QF[d0] = *(const bf16x8*)((const char*)base + 2u * ((QB) + (unsigned)(((N0) + r) * DH + 16 * d0 + 8 * h))); } while (0)
template <int DH, int KT>
__device__ __forceinline__ void att_prime(const bf16_t* __restrict__ base, unsigned Q, unsigned K, unsigned V, int n0, int kt_hi,
                                          bf16x8 (&qf)[DH / 16], bf16x8 (&kf)[KT / 32][DH / 16], u32x4 (&vv)[KT * (DH / 8) / 64], int lane) {
    constexpr int ND = DH / 16, NH = KT / 32, CPR = DH / 8, NCH = KT * CPR / 64;
    const int r = lane & 31, h = lane >> 5;
    ATT_LOAD_Q(Q, n0, qf); ATT_LOAD_K(K, kt_hi, kf); ATT_LOAD_V(V, kt_hi, vv);
}
template <int DH, int KT, int MODE>
__device__ __forceinline__ void attn_item(const bf16_t* __restrict__ base, unsigned K, unsigned V,
                                          int n0, int kt_hi, int kt_lo, float sscale, bf16_t* __restrict__ O, long o_rs, float* __restrict__ lse, long lse_rs,
                                          LAS unsigned char* vimg, int lane,
                                          bf16x8 (&qf)[DH / 16], bf16x8 (&kf)[KT / 32][DH / 16], u32x4 (&vv)[KT * (DH / 8) / 64],
                                          bool has_next, unsigned Qn, unsigned Kn, unsigned Vn, int n0n, int kt_hi_n) {
    constexpr int ND = DH / 16, NH = KT / 32, NB = DH / 32, VP = DH * 2 + 16, CPR = DH / 8, NCH = KT * CPR / 64;
    constexpr bool PFV = true;
    const int r = lane & 31, h = lane >> 5;
    f32x16 o[NB];
#pragma unroll
    for (int db = 0; db < NB; ++db)
#pragma unroll
        for (int i = 0; i < 16; ++i) o[db][i] = 0.f;
    float m_run = -1e30f, l_run = 0.f, R = 1.0f;
    const int qn = n0 + r;
    const LAS unsigned char* vrd = vimg + (4 * h + ((lane & 15) >> 2)) * VP + ((lane >> 4) & 1) * 32 + (lane & 3) * 8;
    bool primed_next = false;
    for (int kt = kt_hi; kt >= kt_lo; --kt) {
        const int key0 = kt * KT;
        if (PFV) { asm volatile("s_waitcnt lgkmcnt(0)" ::: "memory");
#pragma unroll
            for (int i = 0; i < NCH; ++i) { const int c = i * 64 + lane, row = c / CPR, ch = c % CPR; *(LAS u32x4*)(vimg + row * VP + ch * 16) = vv[i]; } }
        f32x16 p[NH];
#pragma unroll
        for (int hf = 0; hf < NH; ++hf) {
#pragma unroll
            for (int i = 0; i < 16; ++i) p[hf][i] = 0.f;
#pragma unroll
            for (int d0 = 0; d0 < ND; ++d0) p[hf] = MFMA32(kf[hf][d0], qf[d0], p[hf]); }
        if (kt > kt_lo) { ATT_LOAD_K(K, kt - 1, kf); ATT_LOAD_V(V, kt - 1, vv); }
        else if (has_next) { ATT_LOAD_Q(Qn, n0n, qf); ATT_LOAD_K(Kn, kt_hi_n, kf); ATT_LOAD_V(Vn, kt_hi_n, vv); primed_next = true; }
        if (MODE == MODE_STICK) {
            float run = R;
#pragma unroll
            for (int hf = NH - 1; hf >= 0; --hf) {
                float beta[16], keep[16];
#pragma unroll
                for (int i = 0; i < 16; ++i) { const float z = __builtin_fmaxf(p[hf][i], -87.0f);
                    const float e = __builtin_amdgcn_exp2f(-1.4426950408889634f * z); const float rr = __builtin_amdgcn_rcpf(1.0f + e);
                    beta[i] = rr; keep[i] = e * rr; }
                if (kt == kt_hi) {
#pragma unroll
                    for (int i = 0; i < 16; ++i) { const int kn = key0 + 32 * hf + crow(i, h); if (kn >= qn) { beta[i] = 0.f; keep[i] = 1.0f; } }
                }
                float G[4], PG[4];
#pragma unroll
                for (int g = 0; g < 4; ++g) { G[g] = (keep[4 * g] * keep[4 * g + 1]) * (keep[4 * g + 2] * keep[4 * g + 3]); PG[g] = xhalf(G[g], h); }
#pragma unroll
                for (int g = 3; g >= 0; --g) {
                    const float c3 = (h == 0) ? run * PG[g] : run;
                    const float c2 = c3 * keep[4 * g + 3], c1 = c2 * keep[4 * g + 2], c0 = c1 * keep[4 * g + 1];
                    p[hf][4 * g + 3] = beta[4 * g + 3] * c3; p[hf][4 * g + 2] = beta[4 * g + 2] * c2; p[hf][4 * g + 1] = beta[4 * g + 1] * c1; p[hf][4 * g] = beta[4 * g] * c0;
                    run = run * (G[g] * PG[g]); }
                __builtin_amdgcn_sched_barrier(0);
            }
            R = run;
        } else {
            const float c2 = (MODE == MODE_XATTN ? sscale : 1.0f) * 1.4426950408889634f;
            float tmax = -1e30f;
            const bool need_mask = (MODE == MODE_BAND) && (kt == kt_hi || key0 < n0 + 31 - 128);
            if (need_mask) { const int dlt = key0 + 4 * h - qn;
#pragma unroll
                for (int hf = 0; hf < NH; ++hf)
#pragma unroll
                    for (int i = 0; i < 16; ++i) { const int dd = dlt + 32 * hf + (i & 3) + 8 * (i >> 2); float s = p[hf][i] * c2; if ((unsigned)(dd + 128) > 128u) s = -1e30f; p[hf][i] = s; tmax = __builtin_fmaxf(tmax, s); }
            } else {
#pragma unroll
                for (int hf = 0; hf < NH; ++hf)
#pragma unroll
                    for (int i = 0; i < 16; ++i) { const float s = p[hf][i] * c2; p[hf][i] = s; tmax = __builtin_fmaxf(tmax, s); }
            }
            tmax = xmax(tmax);
            const float m_new = __builtin_fmaxf(m_run, tmax);
            const float alpha = __builtin_amdgcn_exp2f(m_run - m_new);
            m_run = m_new; l_run *= alpha;
            float ls = 0.f;
#pragma unroll
            for (int hf = 0; hf < NH; ++hf)
#pragma unroll
                for (int i = 0; i < 16; ++i) { const float e = __builtin_amdgcn_exp2f(p[hf][i] - m_new); p[hf][i] = e; ls += e; }
            l_run += ls;
#pragma unroll
            for (int db = 0; db < NB; ++db)
#pragma unroll
                for (int i = 0; i < 16; ++i) o[db][i] *= alpha;
        }
        if (!PFV) { asm volatile("s_waitcnt lgkmcnt(0)" ::: "memory");
#pragma unroll
            for (int i = 0; i < NCH; ++i) { const int c = i * 64 + lane, row = c / CPR, ch = c % CPR; *(LAS u32x4*)(vimg + row * VP + ch * 16) = vv[i]; } }
        asm volatile("s_waitcnt lgkmcnt(0)" ::: "memory");
#pragma unroll
        for (int s = 0; s < KT / 16; ++s) { const int hf = s >> 1, sb = (s & 1) * 8;
            u32x4 pw; pw.x = cvtpk(p[hf][sb], p[hf][sb + 1]); pw.y = cvtpk(p[hf][sb + 2], p[hf][sb + 3]); pw.z = cvtpk(p[hf][sb + 4], p[hf][sb + 5]); pw.w = cvtpk(p[hf][sb + 6], p[hf][sb + 7]);
            const bf16x8 pf = __builtin_bit_cast(bf16x8, pw);
#pragma unroll
            for (int db = 0; db < NB; ++db) { const s16x4 lo = vtr(vrd + (16 * s) * VP + db * 64), hi = vtr(vrd + (16 * s + 8) * VP + db * 64);
                const bf16x8 vf = __builtin_shufflevector(lo, hi, 0, 1, 2, 3, 4, 5, 6, 7);
                o[db] = MFMA32(vf, pf, o[db]); } }
        if (MODE == MODE_STICK) { if (__all(R == 0.0f)) break; }
    }
    float inv = 1.0f;
    if (MODE != MODE_STICK) { const float lt = xsum(l_run); inv = 1.0f / lt;
        if (MODE == MODE_BAND) { if (h == 0) lse[(long)qn * lse_rs] = (m_run + __builtin_log2f(lt)) * 0.6931471805599453f; } }
    bf16_t* orow = O + (long)qn * o_rs + 4 * h;
#pragma unroll
    for (int db = 0; db < NB; ++db)
#pragma unroll
        for (int g = 0; g < 4; ++g) { u32x2 w; w.x = cvtpk(o[db][4 * g] * inv, o[db][4 * g + 1] * inv); w.y = cvtpk(o[db][4 * g + 2] * inv, o[db][4 * g + 3] * inv);
            *(u32x2*)(orow + 32 * db + 8 * g) = w; }
    if (has_next && !primed_next) { ATT_LOAD_Q(Qn, n0n, qf); ATT_LOAD_K(Kn, kt_hi_n, kf); ATT_LOAD_V(Vn, kt_hi_n, vv); }
}

constexpr int XP = 272;
__device__ __forceinline__ void xattn_fill(const bf16_t* __restrict__ Kg, const bf16_t* __restrict__ Vg, LAS unsigned char* kimg, LAS unsigned char* vimg_all, int tid_) {
#pragma unroll
    for (int i = 0; i < 8; ++i) { const int c = i * 512 + tid_, row = c >> 4, ch = c & 15;
        const u32x4 kv = *(const u32x4*)(Kg + (long)row * 1024 + ch * 8), vv = *(const u32x4*)(Vg + (long)row * 1024 + ch * 8);
        *(LAS u32x4*)(kimg + row * XP + ch * 16) = kv; *(LAS u32x4*)(vimg_all + row * XP + ch * 16) = vv; }
}
__device__ __forceinline__ void xattn_q_load(const bf16_t* __restrict__ Q, int n0, bf16x8 (&qf)[8], int lane) {
    const int r = lane & 31, h = lane >> 5;
#pragma unroll
    for (int d0 = 0; d0 < 8; ++d0) qf[d0] = *(const bf16x8*)(Q + (long)(n0 + r) * 128 + 16 * d0 + 8 * h);
}
__device__ __forceinline__ void xattn_item_lds(const bf16x8 (&qf)[8], int n0, float sscale, bf16_t* __restrict__ O, long o_rs, const LAS unsigned char* kimg, const LAS unsigned char* vimg_all, int lane) {
    constexpr int DH = 128, ND = 8, NB = 4;
    const int r = lane & 31, h = lane >> 5;
    f32x16 o[NB];
#pragma unroll
    for (int db = 0; db < NB; ++db)
#pragma unroll
        for (int i = 0; i < 16; ++i) o[db][i] = 0.f;
    float m_run = -1e30f, l_run = 0.f;
    const LAS unsigned char* krd = kimg + r * XP + 16 * h;
    const LAS unsigned char* vrd = vimg_all + (4 * h + ((lane & 15) >> 2)) * XP + ((lane >> 4) & 1) * 32 + (lane & 3) * 8;
    const float c2 = sscale * 1.4426950408889634f;
    for (int kt = 0; kt < 8; ++kt) {
        f32x16 p;
#pragma unroll
        for (int i = 0; i < 16; ++i) p[i] = 0.f;
#pragma unroll
        for (int d0 = 0; d0 < ND; ++d0) { const bf16x8 kf = *(const LAS bf16x8*)(krd + kt * 32 * XP + d0 * 32); p = MFMA32(kf, qf[d0], p); }
        float tmax = -1e30f;
#pragma unroll
        for (int i = 0; i < 16; ++i) { p[i] *= c2; tmax = __builtin_fmaxf(tmax, p[i]); }
        tmax = xmax(tmax);
        if (__any(tmax > m_run + 8.0f)) { const float m_new = __builtin_fmaxf(m_run, tmax), alpha = __builtin_amdgcn_exp2f(m_run - m_new); m_run = m_new; l_run *= alpha;
#pragma unroll
            for (int db = 0; db < NB; ++db)
#pragma unroll
                for (int i = 0; i < 16; ++i) o[db][i] *= alpha; }
        float ls = 0.f;
#pragma unroll
        for (int i = 0; i < 16; ++i) { const float e = __builtin_amdgcn_exp2f(p[i] - m_run); p[i] = e; ls += e; }
        l_run += ls;
#pragma unroll
        for (int s = 0; s < 2; ++s) { const int sb = s * 8;
            u32x4 pw; pw.x = cvtpk(p[sb], p[sb + 1]); pw.y = cvtpk(p[sb + 2], p[sb + 3]); pw.z = cvtpk(p[sb + 4], p[sb + 5]); pw.w = cvtpk(p[sb + 6], p[sb + 7]);
            const bf16x8 pf = __builtin_bit_cast(bf16x8, pw);
#pragma unroll
            for (int db = 0; db < NB; ++db) { const s16x4 lo = vtr(vrd + (kt * 32 + 16 * s) * XP + db * 64), hi = vtr(vrd + (kt * 32 + 16 * s + 8) * XP + db * 64);
                const bf16x8 vf = __builtin_shufflevector(lo, hi, 0, 1, 2, 3, 4, 5, 6, 7);
                o[db] = MFMA32(vf, pf, o[db]); } }
    }
    const float inv = 1.0f / xsum(l_run);
    bf16_t* orow = O + (long)(n0 + r) * o_rs;
#pragma unroll
    for (int db = 0; db < NB; ++db) store_o32(orow + 32 * db, o[db], inv, h);
}

constexpr int BP = 144;
__device__ __forceinline__ void band_fill(const bf16_t* __restrict__ base, unsigned Ko, unsigned Vo, int kr0, int nrows, LAS unsigned char* kimg, LAS unsigned char* vimg2, int tid_) {
    for (int c = tid_; c < nrows * 8; c += 512) { const int row = c >> 3, ch = c & 7; const unsigned eo = (unsigned)((kr0 + row) * 64 + ch * 8);
        const u32x4 kv = *(const u32x4*)((const char*)base + 2u * (Ko + eo)), vv = *(const u32x4*)((const char*)base + 2u * (Vo + eo));
        *(LAS u32x4*)(kimg + row * BP + ch * 16) = kv; *(LAS u32x4*)(vimg2 + row * BP + ch * 16) = vv; }
}

__device__ __forceinline__ void img_load(const bf16_t* __restrict__ base, unsigned Ko, unsigned Vo, int kr0, int nrows, u32x4 (&kreg)[8], u32x4 (&vreg)[8], int tid_) {
#pragma unroll
    for (int i = 0; i < 8; ++i) { const int c = i * 512 + tid_; if (c < nrows * 8) { const int row = c >> 3, ch = c & 7; const unsigned eo = (unsigned)((kr0 + row) * 64 + ch * 8);
        kreg[i] = *(const u32x4*)((const char*)base + 2u * (Ko + eo)); vreg[i] = *(const u32x4*)((const char*)base + 2u * (Vo + eo)); } }
}
__device__ __forceinline__ void img_store(LAS unsigned char* kimg, LAS unsigned char* vimg2, int nrows, const u32x4 (&kreg)[8], const u32x4 (&vreg)[8], int tid_) {
#pragma unroll
    for (int i = 0; i < 8; ++i) { const int c = i * 512 + tid_; if (c < nrows * 8) { const int row = c >> 3, ch = c & 7;
        *(LAS u32x4*)(kimg + row * BP + ch * 16) = kreg[i]; *(LAS u32x4*)(vimg2 + row * BP + ch * 16) = vreg[i]; } }
}
__device__ __forceinline__ void band_item_lds(const bf16_t* __restrict__ base, unsigned Qo, int qrow, int n0, int row0, int kn0, int ntiles, bf16_t* __restrict__ O, long o_rs, float* __restrict__ lse, long lse_rs,
                                              const LAS unsigned char* kimg, const LAS unsigned char* vimg2, int lane) {
    const int r = lane & 31, h = lane >> 5;
    bf16x8 qf[4];
#pragma unroll
    for (int d0 = 0; d0 < 4; ++d0) qf[d0] = *(const bf16x8*)((const char*)base + 2u * (Qo + (unsigned)((qrow + r) * 64 + 16 * d0 + 8 * h)));
    f32x16 o[2];
#pragma unroll
    for (int db = 0; db < 2; ++db)
#pragma unroll
        for (int i = 0; i < 16; ++i) o[db][i] = 0.f;
    float m_run = -1e30f, l_run = 0.f;
    const int qn = n0 + r; const unsigned lo = (unsigned)(qn < 128 ? qn : 128);
    const LAS unsigned char* krd = kimg + (row0 + r) * BP + 16 * h;
    const LAS unsigned char* vrd = vimg2 + (row0 + 4 * h + ((lane & 15) >> 2)) * BP + ((lane >> 4) & 1) * 32 + (lane & 3) * 8;
    for (int j = ntiles - 1; j >= 0; --j) {
        const int key0 = kn0 + 32 * j;
        if (key0 + 31 < 0) break;
        f32x16 p;
#pragma unroll
        for (int i = 0; i < 16; ++i) p[i] = 0.f;
#pragma unroll
        for (int d0 = 0; d0 < 4; ++d0) { const bf16x8 kf = *(const LAS bf16x8*)(krd + j * 32 * BP + d0 * 32); p = MFMA32(kf, qf[d0], p); }
        float tmax = -1e30f;
        const bool need_mask = (j == ntiles - 1) || (key0 < n0 + 31 - 128) || (key0 < 0);
        if (need_mask) { const int dlt = key0 + 4 * h - qn;
#pragma unroll
            for (int i = 0; i < 16; ++i) { const int dd = dlt + (i & 3) + 8 * (i >> 2); float sv = p[i] * 1.4426950408889634f; if ((unsigned)(dd + (int)lo) > lo) sv = -1e30f; p[i] = sv; tmax = __builtin_fmaxf(tmax, sv); }
        } else {
#pragma unroll
            for (int i = 0; i < 16; ++i) { const float sv = p[i] * 1.4426950408889634f; p[i] = sv; tmax = __builtin_fmaxf(tmax, sv); }
        }
        tmax = xmax(tmax);
        if (__any(tmax > m_run + 8.0f)) { const float m_new = __builtin_fmaxf(m_run, tmax), alpha = __builtin_amdgcn_exp2f(m_run - m_new); m_run = m_new; l_run *= alpha;
#pragma unroll
            for (int db = 0; db < 2; ++db)
#pragma unroll
                for (int i = 0; i < 16; ++i) o[db][i] *= alpha; }
        float ls = 0.f;
#pragma unroll
        for (int i = 0; i < 16; ++i) { const float e = __builtin_amdgcn_exp2f(p[i] - m_run); p[i] = e; ls += e; }
        l_run += ls;
#pragma unroll
        for (int s = 0; s < 2; ++s) { const int sb = s * 8;
            u32x4 pw; pw.x = cvtpk(p[sb], p[sb + 1]); pw.y = cvtpk(p[sb + 2], p[sb + 3]); pw.z = cvtpk(p[sb + 4], p[sb + 5]); pw.w = cvtpk(p[sb + 6], p[sb + 7]);
            const bf16x8 pf = __builtin_bit_cast(bf16x8, pw);
#pragma unroll
            for (int db = 0; db < 2; ++db) { const s16x4 lo4 = vtr(vrd + (j * 32 + 16 * s) * BP + db * 64), hi4 = vtr(vrd + (j * 32 + 16 * s + 8) * BP + db * 64);
                const bf16x8 vf = __builtin_shufflevector(lo4, hi4, 0, 1, 2, 3, 4, 5, 6, 7);
                o[db] = MFMA32(vf, pf, o[db]); } }
    }
    const float lt = xsum(l_run), inv = 1.0f / lt;
    if (h == 0) lse[(long)qn * lse_rs] = (m_run + __builtin_log2f(lt)) * 0.6931471805599453f;
    bf16_t* orow = O + (long)qn * o_rs;
#pragma unroll
    for (int db = 0; db < 2; ++db) store_o32(orow + 32 * db, o[db], inv, h);
}

__device__ __forceinline__ bool stick_round_lds(const bf16x8 (&qf)[4], f32x16 (&o)[2], float& R, int n0, int kb_hi, int base_row, const LAS unsigned char* kimg, const LAS unsigned char* vimg2, int lane) {
    const int r = lane & 31, h = lane >> 5, qn = n0 + r;
    const LAS unsigned char* krd = kimg + r * BP + 16 * h;
    const LAS unsigned char* vrd = vimg2 + (4 * h + ((lane & 15) >> 2)) * BP + ((lane >> 4) & 1) * 32 + (lane & 3) * 8;
    for (int kb = kb_hi; kb >= base_row; kb -= 32) {
        const int ro = kb - base_row;
        f32x16 p;
#pragma unroll
        for (int i = 0; i < 16; ++i) p[i] = 0.f;
#pragma unroll
        for (int d0 = 0; d0 < 4; ++d0) { const bf16x8 kf = *(const LAS bf16x8*)(krd + ro * BP + d0 * 32); p = MFMA32(kf, qf[d0], p); }
        float beta[16], keep[16];
#pragma unroll
        for (int i = 0; i < 16; ++i) { const float z = __builtin_fmaxf(p[i], -87.0f); const float e = __builtin_amdgcn_exp2f(-1.4426950408889634f * z); const float rr = __builtin_amdgcn_rcpf(1.0f + e); beta[i] = rr; keep[i] = e * rr; }
        if (kb == n0) {
#pragma unroll
            for (int i = 0; i < 16; ++i) { const int kn = kb + crow(i, h); if (kn >= qn) { beta[i] = 0.f; keep[i] = 1.0f; } }
        }
        float G[4], PG[4];
#pragma unroll
        for (int g = 0; g < 4; ++g) { G[g] = (keep[4 * g] * keep[4 * g + 1]) * (keep[4 * g + 2] * keep[4 * g + 3]); PG[g] = xhalf(G[g], h); }
        float run = R;
#pragma unroll
        for (int g = 3; g >= 0; --g) {
            const float c3 = (h == 0) ? run * PG[g] : run;
            const float c2 = c3 * keep[4 * g + 3], c1 = c2 * keep[4 * g + 2], c0 = c1 * keep[4 * g + 1];
            p[4 * g + 3] = beta[4 * g + 3] * c3; p[4 * g + 2] = beta[4 * g + 2] * c2; p[4 * g + 1] = beta[4 * g + 1] * c1; p[4 * g] = beta[4 * g] * c0;
            run = run * (G[g] * PG[g]); }
        R = run;
#pragma unroll
        for (int s = 0; s < 2; ++s) { const int sb = s * 8;
            u32x4 pw; pw.x = cvtpk(p[sb], p[sb + 1]); pw.y = cvtpk(p[sb + 2], p[sb + 3]); pw.z = cvtpk(p[sb + 4], p[sb + 5]); pw.w = cvtpk(p[sb + 6], p[sb + 7]);
            const bf16x8 pf = __builtin_bit_cast(bf16x8, pw);
#pragma unroll
            for (int db = 0; db < 2; ++db) { const s16x4 lo4 = vtr(vrd + (ro + 16 * s) * BP + db * 64), hi4 = vtr(vrd + (ro + 16 * s + 8) * BP + db * 64);
                const bf16x8 vf = __builtin_shufflevector(lo4, hi4, 0, 1, 2, 3, 4, 5, 6, 7);
                o[db] = MFMA32(vf, pf, o[db]); } }
        if (__all(R == 0.0f)) return true;
    }
    return false;
}
#undef ATT_LOAD_K
#undef ATT_LOAD_V
#undef ATT_LOAD_Q
#undef LAS
}
#define LAS __attribute__((address_space(3)))
typedef unsigned short bf16;
typedef unsigned v4u __attribute__((ext_vector_type(4)));
typedef unsigned v2u __attribute__((ext_vector_type(2)));
typedef float f32x4 __attribute__((ext_vector_type(4)));
constexpr int NWAVES = 8, NTHREADS = 512;
constexpr int T = 65536, D = 1024, SEQ = 2048, NB_ = 32, DIN = 4352, DFF = 2816, MEMT = 8192;
constexpr float EPS = 1e-6f;
constexpr int XNP = 1280, OP = 1280;
constexpr size_t MiB = 1u << 20;
constexpr size_t OFF_WIN = 0;
constexpr size_t OFF_WGATE = OFF_WIN + 4352ull * 1024 * 2;
constexpr size_t OFF_WSB = OFF_WGATE + 3072ull * 1024 * 2;
constexpr size_t OFF_WDIL = OFF_WSB + 1024ull * 512 * 2;
constexpr size_t OFF_WMEM = OFF_WDIL + 1024ull * 256 * 2;
constexpr size_t OFF_WO = OFF_WMEM + 1024ull * 512 * 2;
constexpr size_t OFF_WFI = OFF_WO + 1024ull * 1024 * 2;
constexpr size_t OFF_WFO = OFF_WFI + 5632ull * 1024 * 2;
constexpr size_t OFF_WKV = OFF_WFO + 1024ull * 2816 * 2;
constexpr size_t OFF_ROPE = OFF_WKV + 1024ull * 1024 * 2;
constexpr size_t OFF_MEMN = OFF_ROPE + 2048ull * 64 * 4;
constexpr size_t OFF_KVM = OFF_MEMN + 8192ull * 1024 * 2;
constexpr size_t OFF_R1 = 72 * MiB;
constexpr size_t OFF_R2 = OFF_R1 + 544 * MiB;
constexpr size_t WS_END = OFF_R2 + 352 * MiB;
static_assert(OFF_KVM + 8192ull * 1024 * 2 <= OFF_R1, "ws map");
constexpr size_t OFF_PROJ = OFF_R1, OFF_GS = OFF_R1, OFF_MERGED = OFF_R1 + 128 * MiB, OFF_XN2 = OFF_R1 + 256 * MiB, OFF_FO = OFF_R1 + 384 * MiB;
constexpr size_t OFF_OBG = OFF_R2, OFF_LSE = OFF_R2 + 96 * MiB, OFF_OA = OFF_R2 + 100 * MiB, OFF_OB = OFF_R2 + 164 * MiB, OFF_OC = OFF_R2 + 196 * MiB, OFF_MIX = OFF_R1, OFF_F = OFF_R2;
constexpr int LDS_BYTES = 147456;

__device__ __forceinline__ unsigned f2bf(float f) { unsigned u = __builtin_bit_cast(unsigned, f); return (u + 0x7fffu + ((u >> 16) & 1u)) >> 16; }
__device__ __forceinline__ unsigned pk2(float lo, float hi) { return f2bf(lo) | (f2bf(hi) << 16); }
__device__ __forceinline__ float wave_sum(float v) {
#pragma unroll
    for (int o = 1; o < 64; o <<= 1) v += __shfl_xor(v, o);
    return v;
}
template <int MAP> __device__ __forceinline__ int map_row(int n) {
    if (MAP == 1) { if (n >= 1536 && n < 3840 && (((n - 1536) >> 8) % 3) != 2) return (n & ~63) + 2 * (n & 31) + ((n >> 5) & 1); return n; }
    if (MAP == 2) { const int f = n < DFF ? n : n - DFF; return (f >> 7) * 256 + (n < DFF ? 0 : 128) + (f & 127); }
    return n;
}
template <int MAP> __device__ __forceinline__ void transpose_item(const float* __restrict__ W, int K, int N, bf16* __restrict__ WT, int ldw, int coff, LAS float* scr, int item, int lane_) {
    const int nblk = N / 32, kb = item / nblk, nb = item % nblk, k0 = 64 * kb, n0 = 32 * nb;
#pragma unroll 8
    for (int i = 0; i < 32; ++i) { const int kk = 2 * i + (lane_ >> 5); scr[kk * 33 + (lane_ & 31)] = __builtin_nontemporal_load(W + (size_t)(k0 + kk) * N + n0 + (lane_ & 31)); }
    asm volatile("s_waitcnt lgkmcnt(0)" ::: "memory");
    const int c = lane_ & 7;
#pragma unroll
    for (int j = 0; j < 4; ++j) { const int n = (lane_ >> 3) + 8 * j; const LAS float* s = scr + (8 * c) * 33 + n;
        v4u o; o.x = pk2(s[0 * 33], s[1 * 33]); o.y = pk2(s[2 * 33], s[3 * 33]); o.z = pk2(s[4 * 33], s[5 * 33]); o.w = pk2(s[6 * 33], s[7 * 33]);
        const int nn = n0 + n; const size_t dst = (MAP == 3) ? (size_t)(nn & 1023) * ldw + (nn >> 10) * 1024 : (size_t)map_row<MAP>(nn) * ldw + coff;
        *(v4u*)(WT + dst + k0 + 8 * c) = o; }
    asm volatile("s_waitcnt lgkmcnt(0)" ::: "memory");
}
__device__ __forceinline__ void rms_row_to_bf16(const float* __restrict__ xrow, const float* __restrict__ g, bf16* __restrict__ orow, int lane) {
    const f32x4* xr = (const f32x4*)xrow + lane; const f32x4* gr = (const f32x4*)g + lane;
    f32x4 v[4]; float s = 0.f;
#pragma unroll
    for (int j = 0; j < 4; ++j) { v[j] = xr[64 * j]; s += (v[j].x * v[j].x + v[j].y * v[j].y) + (v[j].z * v[j].z + v[j].w * v[j].w); }
    const float rstd = 1.0f / sqrtf(wave_sum(s) * (1.0f / D) + EPS);
    unsigned long long* o8 = (unsigned long long*)orow + lane;
#pragma unroll
    for (int j = 0; j < 4; ++j) { const f32x4 gg = gr[64 * j];
        o8[64 * j] = (unsigned long long)pk2(v[j].x * rstd * gg.x, v[j].y * rstd * gg.y) | ((unsigned long long)pk2(v[j].z * rstd * gg.z, v[j].w * rstd * gg.w) << 32); }
}
__device__ __forceinline__ void rms_row2_to_bf16(const float* __restrict__ xa, const float* __restrict__ xb, const float* __restrict__ g, bf16* __restrict__ oa, bf16* __restrict__ ob, int lane_) {
    const f32x4* ra = (const f32x4*)xa + lane_; const f32x4* rb = (const f32x4*)xb + lane_; const f32x4* gr = (const f32x4*)g + lane_;
    f32x4 va[4], vb[4]; float sa = 0.f, sb = 0.f;
#pragma unroll
    for (int j = 0; j < 4; ++j) { va[j] = __builtin_nontemporal_load(ra + 64 * j); vb[j] = __builtin_nontemporal_load(rb + 64 * j); }
#pragma unroll
    for (int j = 0; j < 4; ++j) { sa += (va[j].x * va[j].x + va[j].y * va[j].y) + (va[j].z * va[j].z + va[j].w * va[j].w); sb += (vb[j].x * vb[j].x + vb[j].y * vb[j].y) + (vb[j].z * vb[j].z + vb[j].w * vb[j].w); }
    const float rsa = 1.0f / sqrtf(wave_sum(sa) * (1.0f / D) + EPS), rsb = 1.0f / sqrtf(wave_sum(sb) * (1.0f / D) + EPS);
    unsigned long long* pa = (unsigned long long*)oa + lane_; unsigned long long* pb = (unsigned long long*)ob + lane_;
#pragma unroll
    for (int j = 0; j < 4; ++j) { const f32x4 gg = gr[64 * j];
        pa[64 * j] = (unsigned long long)pk2(va[j].x * rsa * gg.x, va[j].y * rsa * gg.y) | ((unsigned long long)pk2(va[j].z * rsa * gg.z, va[j].w * rsa * gg.w) << 32);
        pb[64 * j] = (unsigned long long)pk2(vb[j].x * rsb * gg.x, vb[j].y * rsb * gg.y) | ((unsigned long long)pk2(vb[j].z * rsb * gg.z, vb[j].w * rsb * gg.w) << 32); }
}
__device__ __forceinline__ float bfl(unsigned w) { return __uint_as_float(w << 16); }
__device__ __forceinline__ float bfh(unsigned w) { return __uint_as_float(w & 0xffff0000u); }

#define XB_TMO      128
#define XB_XCNT(j)  (256  + 64 * (j))
#define XB_XSUB(j)  (1280 + 64 * (j))
#define XB_XGEN(j)  (2304 + 64 * (j))
#define XB_TOP      3328
#define XB_TOPGEN   3392
#define XCD_BAR_WORDS 3456
#define XB_SPIN_CAP (1u << 18)

__device__ __forceinline__ unsigned xb_ld(unsigned* p)              { return __hip_atomic_load(p, __ATOMIC_RELAXED, __HIP_MEMORY_SCOPE_AGENT); }
__device__ __forceinline__ unsigned xb_add(unsigned* p, unsigned v) { return __hip_atomic_fetch_add(p, v, __ATOMIC_RELAXED, __HIP_MEMORY_SCOPE_AGENT); }
__device__ __forceinline__ unsigned xb_xcc_id() { return (unsigned)__builtin_amdgcn_s_getreg((3 << 11) | 20) & 0xFu; }
#define XB_SPIN(cond, bar) do { unsigned _sp = 0; while (cond) { __builtin_amdgcn_s_sleep(1); \
    if ((++_sp & 255u) == 0u) { if (xb_ld(&(bar)[XB_TMO])) break; if (_sp > XB_SPIN_CAP) { atomicAdd(&(bar)[XB_TMO], 1u); break; } } } } while (0)

struct XcdBarrier {
    unsigned* bar; unsigned x;
    volatile LAS unsigned* st;
};

__device__ __forceinline__ XcdBarrier xcd_barrier_post(unsigned* bar, volatile LAS unsigned* st) {
    XcdBarrier b; b.bar = bar; b.x = xb_xcc_id(); b.st = st;
    if (threadIdx.x == 0) (void)xb_add(&bar[XB_XCNT(b.x)], 1u);
    return b;
}
__device__ __forceinline__ void xcd_barrier_complete(unsigned* bar, unsigned x, unsigned& nloc, unsigned& nx) {
    const unsigned G = gridDim.x * gridDim.y * gridDim.z;
    unsigned sum, cnt, mine, sp = 0u;
    for (;;) {
        sum = 0u; cnt = 0u; mine = 0u;
#pragma unroll
        for (unsigned j = 0; j < 16; ++j) { const unsigned c = xb_ld(&bar[XB_XCNT(j)]); sum += c; cnt += (c > 0u) ? 1u : 0u; mine = (j == x) ? c : mine; }
        if (sum == G) break;
        __builtin_amdgcn_s_sleep(1);
        if ((++sp & 255u) == 0u) { if (xb_ld(&bar[XB_TMO])) break; if (sp > XB_SPIN_CAP) { atomicAdd(&bar[XB_TMO], 1u); break; } }
    }
    nloc = mine > 0u ? mine : 1u; nx = cnt > 0u ? cnt : 1u;
}

__device__ __forceinline__ void xcd_barrier(const XcdBarrier& b) {
    asm volatile("s_waitcnt vmcnt(0)" ::: "memory");
    __syncthreads();
    if (threadIdx.x == 0) {
        unsigned* bar = b.bar;
        __builtin_amdgcn_s_waitcnt(0);
        unsigned nloc = b.st[0], nx = b.st[1];
        if (nloc == 0u) { xcd_barrier_complete(bar, b.x, nloc, nx); b.st[0] = nloc; b.st[1] = nx; }
        const unsigned old = xb_add(&bar[XB_XSUB(b.x)], 1u);
        const unsigned gen = old / nloc;
        if (old + 1u == (gen + 1u) * nloc) {
            __builtin_amdgcn_fence(__ATOMIC_RELEASE, "agent");
            asm volatile("s_waitcnt vmcnt(0)" ::: "memory");
            const unsigned og = xb_add(&bar[XB_TOP], 1u);
            const unsigned tg = og / nx;
            if (og + 1u == (tg + 1u) * nx) xb_add(&bar[XB_TOPGEN], 1u);
            else XB_SPIN(xb_ld(&bar[XB_TOPGEN]) == tg, bar);
            __builtin_amdgcn_fence(__ATOMIC_ACQUIRE, "agent");
            xb_add(&bar[XB_XGEN(b.x)], 1u);
            asm volatile("s_waitcnt vmcnt(0)" ::: "memory");
        } else {
            XB_SPIN(xb_ld(&bar[XB_XGEN(b.x)]) == gen, bar);
            __builtin_amdgcn_fence(__ATOMIC_ACQUIRE, "agent");
            asm volatile("s_waitcnt vmcnt(0)" ::: "memory");
        }
    }
    __syncthreads();
}

constexpr size_t OFF_BAR = 970 * MiB;
constexpr int MISC_OFF = 147456 - 16 - 32;
struct Args { const float* in[17]; float* out; unsigned char* ws; };

__global__ void __launch_bounds__(NTHREADS) fwd_megakernel(Args a) {
    extern __shared__ __attribute__((aligned(16))) unsigned char lds_raw[];
    cg::grid_group grid = cg::this_grid();
    LAS unsigned char* lds = (LAS unsigned char*)lds_raw;
#define tid ((int)threadIdx.x)
#define lane ((int)threadIdx.x & 63)
#define wave (__builtin_amdgcn_readfirstlane((int)threadIdx.x >> 6))
#define G ((int)gridDim.x)
#define bx ((int)blockIdx.x)
#define gw (bx * NWAVES + wave)
#define NGW (G * NWAVES)
#define xin (a.in[0])
#define mem (a.in[1])
#define g_pre_mix (a.in[2])
#define g_post_mix (a.in[3])
#define g_pre_ffn (a.in[4])
#define g_post_ffn (a.in[5])
#define g_mem (a.in[6])
#define w_in (a.in[7])
#define w_mem_kv (a.in[8])
#define w_br_sb (a.in[9])
#define w_br_dil (a.in[10])
#define w_br_mem (a.in[11])
#define w_gate (a.in[12])
#define b_gate (a.in[13])
#define w_o (a.in[14])
#define w_ffn_in (a.in[15])
#define w_ffn_out (a.in[16])
#define XN ((bf16*)a.out)
#define WIN ((bf16*)(a.ws + OFF_WIN))
#define WCAT ((bf16*)(a.ws + OFF_WGATE))
#define WSB ((bf16*)(a.ws + OFF_WSB))
#define WDIL ((bf16*)(a.ws + OFF_WDIL))
#define WMEM ((bf16*)(a.ws + OFF_WMEM))
#define WO ((bf16*)(a.ws + OFF_WO))
#define WFI ((bf16*)(a.ws + OFF_WFI))
#define WFO ((bf16*)(a.ws + OFF_WFO))
#define WKV ((bf16*)(a.ws + OFF_WKV))
#define MEMN ((bf16*)(a.ws + OFF_MEMN))
#define KVM ((bf16*)(a.ws + OFF_KVM))
#define ROPE ((float*)(a.ws + OFF_ROPE))
#define PROJ ((bf16*)(a.ws + OFF_PROJ))
#define GS ((bf16*)(a.ws + OFF_GS))
#define MERGED ((bf16*)(a.ws + OFF_MERGED))
#define XN2 ((bf16*)(a.ws + OFF_XN2))
#define FO ((bf16*)(a.ws + OFF_FO))
#define OBG ((bf16*)(a.ws + OFF_OBG))
#define OA ((bf16*)(a.ws + OFF_OA))
#define OB (OA + 512)
#define OC (OA + 768)
#define MIX ((bf16*)(a.ws + OFF_MIX))
#define FB ((bf16*)(a.ws + OFF_F))
#define LSE ((float*)(a.ws + OFF_LSE))
    volatile LAS unsigned* MISC = (volatile LAS unsigned*)(lds + MISC_OFF);
    if (tid < 2) MISC[8 + tid] = 0u;
    unsigned* barw = (unsigned*)(a.ws + OFF_BAR);
    if (bx == 0) for (int i = tid; i < XCD_BAR_WORDS; i += NTHREADS) barw[i] = 0u;
    __syncthreads();

    {
        LAS float* scr = (LAS float*)(lds + wave * 16384);
        constexpr int I_IN = 16 * (DIN / 32), I_G = 16 * (3072 / 32), I_SB = 8 * 32, I_DIL = 4 * 32, I_MEM = 8 * 32, I_O = 16 * 32, I_FI = 16 * (5632 / 32), I_FO = 44 * 32, I_KV = 16 * 32;
        constexpr int NITEMS = I_IN + I_G + I_SB + I_DIL + I_MEM + I_O + I_FI + I_FO + I_KV;
        for (int it = gw; it < NITEMS; it += NGW) {
            int r = it;
            if (r < I_IN) { transpose_item<1>(w_in, 1024, DIN, WIN, 1024, 0, scr, r, lane); continue; } r -= I_IN;
            if (r < I_G) { transpose_item<3>(w_gate, 1024, 3072, WCAT, 4352, 0, scr, r, lane); continue; } r -= I_G;
            if (r < I_SB) { transpose_item<0>(w_br_sb, 512, 1024, WCAT, 4352, 3072, scr, r, lane); continue; } r -= I_SB;
            if (r < I_DIL) { transpose_item<0>(w_br_dil, 256, 1024, WCAT, 4352, 3584, scr, r, lane); continue; } r -= I_DIL;
            if (r < I_MEM) { transpose_item<0>(w_br_mem, 512, 1024, WCAT, 4352, 3840, scr, r, lane); continue; } r -= I_MEM;
            if (r < I_O) { transpose_item<0>(w_o, 1024, 1024, WO, 1024, 0, scr, r, lane); continue; } r -= I_O;
            if (r < I_FI) { transpose_item<2>(w_ffn_in, 1024, 5632, WFI, 1024, 0, scr, r, lane); continue; } r -= I_FI;
            if (r < I_FO) { transpose_item<0>(w_ffn_out, DFF, 1024, WFO, DFF, 0, scr, r, lane); continue; } r -= I_FO;
            transpose_item<0>(w_mem_kv, 1024, 1024, WKV, 1024, 0, scr, r, lane);
        }
        for (int m = gw; m < T; m += 2 * NGW) { const int mb = (m + NGW < T) ? m + NGW : m; rms_row2_to_bf16(xin + (size_t)m * D, xin + (size_t)mb * D, g_pre_mix, XN + (size_t)m * XNP, XN + (size_t)mb * XNP, lane); }
        for (int m = gw; m < MEMT; m += 2 * NGW) { const int mb = (m + NGW < MEMT) ? m + NGW : m; rms_row2_to_bf16(mem + (size_t)m * D, mem + (size_t)mb * D, g_mem, MEMN + (size_t)m * D, MEMN + (size_t)mb * D, lane); }
        for (int i = bx * NTHREADS + tid; i < SEQ * 32; i += G * NTHREADS) { const int pos = i >> 5, j = i & 31;
            const float inv_freq = exp2f(-(float)j * (13.287712379549449f / 32.0f));
            const float ang = (float)pos * inv_freq;
            double t = (double)ang * 0.15915494309189535; t -= rint(t);
            const float tf = (float)t;
            ROPE[2 * i] = __builtin_amdgcn_cosf(tf); ROPE[2 * i + 1] = __builtin_amdgcn_sinf(tf); }
    }
    grid.sync();
    (void)xcd_barrier_post(barw, MISC + 8);
#define GRID_BAR() do { XcdBarrier xb_; xb_.bar = (unsigned*)(a.ws + OFF_BAR); xb_.x = xb_xcc_id(); xb_.st = (volatile LAS unsigned*)(lds + MISC_OFF) + 8; xcd_barrier(xb_); } while (0)

    {
        pg8::Gemm g{XN, WIN, T, DIN, D, XNP, D}; pg8::StaticOrder S; S.init(T, DIN, G, bx);
        pg8::EpiProj E{PROJ, ROPE};
        pg8::gemm_phase<pg8::EpiProj, pg8::StaticOrder, true, true>(lds, g, S, E);
    }
    {
        pg8::Gemm g{MEMN, WKV, MEMT, 1024, D}; pg8::StaticOrder S; S.init(MEMT, 1024, G, bx);
        pg8::EpiPlain E{KVM, 1024};
        pg8::gemm_phase<pg8::EpiPlain, pg8::StaticOrder, true, true>(lds, g, S, E);
    }
    GRID_BAR();

    LAS unsigned char* vimg = lds + wave * 16384;
    {
        for (int c = bx; c < NB_ * 8; c += G) {
            const int b = c >> 3, hh = (c >> 1) & 3, h2 = c & 1;
#define BAND_STEP(ST, G_, SH_, RHO_, NB0_, IMG_, KR0_, NROWS_) \
                const int G_ = (ST) >> 2, s4_##G_ = (ST) & 3, SH_ = 2 * G_, L_##G_ = SEQ >> SH_; \
                const int RHO_ = (G_ == 0) ? 0 : (G_ == 1 ? s4_##G_ : 4 * s4_##G_);                         \
                const int NB0_ = (G_ == 0) ? 1024 * h2 + 256 * s4_##G_ : (G_ == 1 ? 256 * h2 : 0);     \
                const unsigned IMG_ = (unsigned)(3 * pg8::SZ64 + (size_t)(3 * G_) * pg8::SZ32 + ((size_t)(b * 4 + hh) * 2048 + RHO_ * L_##G_) * 64);     \
                const int KR0_ = (G_ < 2) ? NB0_ - 128 : 0, NROWS_ = (G_ < 2) ? 384 : 512;
            att::u32x4 kreg[8], vreg[8];
            { BAND_STEP(0, g0_, sh0_, rho0_, nb00_, img0_, kr00_, nrows0_) (void)sh0_; (void)rho0_; (void)nb00_;
              att::img_load(PROJ, img0_ + (unsigned)pg8::SZ32, img0_ + 2u * (unsigned)pg8::SZ32, kr00_, nrows0_, kreg, vreg, tid); }
            for (int st = 0; st < 12; ++st) {
                BAND_STEP(st, g, sh, rho, nb0, img, kr0, nrows) (void)kr0;
                __syncthreads();
                att::img_store(lds, lds + 512 * att::BP, nrows, kreg, vreg, tid);
                __syncthreads();
                if (st < 11) { BAND_STEP(st + 1, gn, shn, rhon, nb0n, imgn, kr0n, nrowsn) (void)shn; (void)rhon; (void)nb0n;
                    att::img_load(PROJ, imgn + (unsigned)pg8::SZ32, imgn + 2u * (unsigned)pg8::SZ32, kr0n, nrowsn, kreg, vreg, tid); }
                int n0, qrow, row0, kn0, ntiles, rho_w;
                if (g < 2) { n0 = nb0 + 32 * wave; qrow = n0; row0 = 32 * wave; kn0 = nb0 - 128 + 32 * wave; ntiles = 5; rho_w = rho; }
                else { const int res = wave >> 1, qt = wave & 1; n0 = 64 * h2 + 32 * qt; qrow = 128 * res + n0; row0 = 128 * res; kn0 = 0; ntiles = (n0 >> 5) + 1; rho_w = rho + res; }
                bf16* ob = OBG + (size_t)g * T * 256 + ((size_t)b * SEQ + rho_w) * 256 + hh * 64;
                float* ls = LSE + (size_t)g * T * 4 + ((size_t)b * SEQ + rho_w) * 4 + hh;
                att::band_item_lds(PROJ, img, qrow, n0, row0, kn0, ntiles, ob, (long)(256 << sh), ls, (long)(4 << sh), lds, lds + 512 * att::BP, lane);
            }
#undef BAND_STEP
            asm volatile("s_waitcnt vmcnt(0)" ::: "memory"); __syncthreads();
            for (int i = tid; i < 1024 * 8; i += NTHREADS) {
                const int ch = i & 7; const size_t t = (size_t)b * SEQ + 1024 * h2 + (i >> 3);
                const float l0 = LSE[t * 4 + hh], l1 = LSE[(size_t)T * 4 + t * 4 + hh], l2 = LSE[(size_t)2 * T * 4 + t * 4 + hh];
                const float mx = fmaxf(l0, fmaxf(l1, l2));
                float a0 = __expf(l0 - mx), a1 = __expf(l1 - mx), a2 = __expf(l2 - mx); const float is = 1.0f / (a0 + a1 + a2); a0 *= is; a1 *= is; a2 *= is;
                const size_t off = t * 256 + hh * 64 + ch * 8;
                const v4u p0 = *(const v4u*)(OBG + off), p1 = *(const v4u*)(OBG + (size_t)T * 256 + off), p2 = *(const v4u*)(OBG + (size_t)2 * T * 256 + off);
                v4u o;
                o.x = pk2(a0 * bfl(p0.x) + a1 * bfl(p1.x) + a2 * bfl(p2.x), a0 * bfh(p0.x) + a1 * bfh(p1.x) + a2 * bfh(p2.x));
                o.y = pk2(a0 * bfl(p0.y) + a1 * bfl(p1.y) + a2 * bfl(p2.y), a0 * bfh(p0.y) + a1 * bfh(p1.y) + a2 * bfh(p2.y));
                o.z = pk2(a0 * bfl(p0.z) + a1 * bfl(p1.z) + a2 * bfl(p2.z), a0 * bfh(p0.z) + a1 * bfh(p1.z) + a2 * bfh(p2.z));
                o.w = pk2(a0 * bfl(p0.w) + a1 * bfl(p1.w) + a2 * bfl(p2.w), a0 * bfh(p0.w) + a1 * bfh(p1.w) + a2 * bfh(p2.w));
                *(v4u*)(OB + t * OP + hh * 64 + ch * 8) = o;
            }
        }
        for (int c = bx; c < NB_ * 8; c += G) {
            const int b = c >> 3, hh = c & 7;
            const unsigned qb = (unsigned)((size_t)(b * 8 + hh) * 2048 * 64);
            bf16* ob = OA + (size_t)b * SEQ * OP + hh * 64;
            att::u32x4 kreg[8], vreg[8];
            att::img_load(PROJ, qb + (unsigned)pg8::SZ64, qb + 2u * (unsigned)pg8::SZ64, 0, 256, kreg, vreg, tid);
            for (int st = 0; st < 8; ++st) {
                const int n0 = 256 * st + 32 * wave, r_ = lane & 31, h_ = lane >> 5;
                att::bf16x8 qf[4]; att::f32x16 o[2]; float R = 1.0f; bool done = false;
#pragma unroll
                for (int d0 = 0; d0 < 4; ++d0) qf[d0] = *(const att::bf16x8*)((const char*)PROJ + 2u * (qb + (unsigned)((n0 + r_) * 64 + 16 * d0 + 8 * h_)));
#pragma unroll
                for (int db = 0; db < 2; ++db)
#pragma unroll
                    for (int i = 0; i < 16; ++i) o[db][i] = 0.f;
                int top = 256 * st + 256; bool first_round = true;
                for (;;) {
                    const int base_row = top > 480 ? top - 480 : 0;
                    __syncthreads();
                    if (first_round) att::img_store(lds, lds + 480 * att::BP, top - base_row, kreg, vreg, tid);
                    else att::band_fill(PROJ, qb + (unsigned)pg8::SZ64, qb + 2u * (unsigned)pg8::SZ64, base_row, top - base_row, lds, lds + 480 * att::BP, tid);
                    __syncthreads();
                    if (first_round && st < 7) { const int topn = 256 * st + 512, basen = topn > 480 ? topn - 480 : 0;
                        att::img_load(PROJ, qb + (unsigned)pg8::SZ64, qb + 2u * (unsigned)pg8::SZ64, basen, topn - basen, kreg, vreg, tid); }
                    first_round = false;
                    if (!done) { const int kb_hi = n0 < top - 32 ? n0 : top - 32;
                        done = att::stick_round_lds(qf, o, R, n0, kb_hi, base_row, lds, lds + 480 * att::BP, lane) || (base_row == 0); }
                    if (!__syncthreads_or(done ? 0 : 1)) break;
                    top = base_row;
                }
                bf16* orow = ob + (size_t)(n0 + r_) * OP;
#pragma unroll
                for (int db = 0; db < 2; ++db) att::store_o32(orow + 32 * db, o[db], 1.0f, h_);
            }
        }
        for (int c = bx; c < NB_ * 8; c += G) {
            const int b = c >> 3, hh = (c >> 1) & 3, half = c & 1;
            const bf16* qb = PROJ + 3 * pg8::SZ64 + 9 * pg8::SZ32 + (size_t)(b * 4 + hh) * 2048 * 128;
            const bf16* kb = KVM + (size_t)b * 256 * 1024 + hh * 128;
            bf16* ob = OC + (size_t)b * SEQ * OP + hh * 128;
            __syncthreads();
            att::xattn_fill(kb, kb + 512, lds, lds + 256 * att::XP, tid);
            __syncthreads();
            att::bf16x8 xq[8], xqn[8];
            att::xattn_q_load(qb, (32 * half + wave) * 32, xq, lane);
            for (int k = 0; k < 4; ++k) { const int n0 = (32 * half + wave + 8 * k) * 32;
                if (k < 3) att::xattn_q_load(qb, n0 + 256, xqn, lane);
                att::xattn_item_lds(xq, n0, 0.08838834764831845f, ob, OP, lds, lds + 256 * att::XP, lane);
#pragma unroll
                for (int d0 = 0; d0 < 8; ++d0) xq[d0] = xqn[d0]; }
        }
        __syncthreads();
    }
    GRID_BAR();

    {
        pg8::Gemm g{XN, WCAT, T, 1024, D, XNP, 4352}; pg8::P3Order S; S.S.init(T, 1024, G, bx); S.xnp = XN; S.oabc = OA; S.wcat = WCAT;
        pg8::EpiP3 E{GS, MERGED, b_gate};
        pg8::gemm_phase<pg8::EpiP3, pg8::P3Order, true, true, true>(lds, g, S, E);
    }
    GRID_BAR();

    {
        pg8::Gemm g{MERGED, WO, T, 1024, D}; pg8::StaticOrder S; S.init(T, 1024, G, bx);
        pg8::EpiPlain E{MIX, 1024};
        pg8::gemm_phase<pg8::EpiPlain, pg8::StaticOrder, true, true>(lds, g, S, E);
    }
    GRID_BAR();

    {
        for (int m0 = gw; m0 < T; m0 += 2 * NGW) {
            f32x4 v[2][4], xx[2][4]; float s[2] = {0.f, 0.f}, s2[2] = {0.f, 0.f};
#pragma unroll
            for (int u = 0; u < 2; ++u) { const int m = (m0 + u * NGW < T) ? m0 + u * NGW : m0;     const v2u* mr = (const v2u*)(MIX + (size_t)m * D) + lane; const f32x4* xr = (const f32x4*)(xin + (size_t)m * D) + lane;
#pragma unroll
                for (int j = 0; j < 4; ++j) { const v2u w = __builtin_nontemporal_load(mr + 64 * j); xx[u][j] = __builtin_nontemporal_load(xr + 64 * j); v[u][j] = (f32x4){bfl(w.x), bfh(w.x), bfl(w.y), bfh(w.y)}; } }
#pragma unroll
            for (int u = 0; u < 2; ++u)
#pragma unroll
                for (int j = 0; j < 4; ++j) s[u] += (v[u][j].x * v[u][j].x + v[u][j].y * v[u][j].y) + (v[u][j].z * v[u][j].z + v[u][j].w * v[u][j].w);
#pragma unroll
            for (int u = 0; u < 2; ++u) { const float rstd = 1.0f / sqrtf(wave_sum(s[u]) * (1.0f / D) + EPS);
#pragma unroll
                for (int j = 0; j < 4; ++j) { const f32x4 gg = ((const f32x4*)g_post_mix + lane)[64 * j]; v[u][j] = xx[u][j] + v[u][j] * rstd * gg; s2[u] += (v[u][j].x * v[u][j].x + v[u][j].y * v[u][j].y) + (v[u][j].z * v[u][j].z + v[u][j].w * v[u][j].w); } }
#pragma unroll
            for (int u = 0; u < 2; ++u) { const float rstd2 = 1.0f / sqrtf(wave_sum(s2[u]) * (1.0f / D) + EPS); unsigned long long* o8 = (unsigned long long*)(XN2 + (size_t)((m0 + u * NGW < T) ? m0 + u * NGW : m0) * D) + lane;
#pragma unroll
                for (int j = 0; j < 4; ++j) { const f32x4 gg = ((const f32x4*)g_pre_ffn + lane)[64 * j];
                    o8[64 * j] = (unsigned long long)pk2(v[u][j].x * rstd2 * gg.x, v[u][j].y * rstd2 * gg.y) | ((unsigned long long)pk2(v[u][j].z * rstd2 * gg.z, v[u][j].w * rstd2 * gg.w) << 32); } }
        }
    }
    GRID_BAR();

    {
        pg8::Gemm g{XN2, WFI, T, 2 * DFF, D}; pg8::StaticOrder S; S.init(T, 2 * DFF, G, bx);
        pg8::EpiSwiglu E{FB};
        pg8::gemm_phase<pg8::EpiSwiglu, pg8::StaticOrder, true, true>(lds, g, S, E);
    }
    GRID_BAR();

    {
        pg8::Gemm g{FB, WFO, T, 1024, DFF}; pg8::StaticOrder S; S.init(T, 1024, G, bx);
        pg8::EpiPlain E{FO, 1024};
        pg8::gemm_phase<pg8::EpiPlain, pg8::StaticOrder, true, true>(lds, g, S, E);
    }
    GRID_BAR();

    {
        for (int m0 = gw; m0 < T; m0 += 2 * NGW) {
            f32x4 v[2][4], f[2][4], xx[2][4]; float s[2] = {0.f, 0.f}, s3[2] = {0.f, 0.f};
#pragma unroll
            for (int u = 0; u < 2; ++u) { const int m = (m0 + u * NGW < T) ? m0 + u * NGW : m0;     const v2u* mr = (const v2u*)(MIX + (size_t)m * D) + lane; const v2u* fr_ = (const v2u*)(FO + (size_t)m * D) + lane; const f32x4* xr = (const f32x4*)(xin + (size_t)m * D) + lane;
#pragma unroll
                for (int j = 0; j < 4; ++j) { const v2u w = __builtin_nontemporal_load(mr + 64 * j), q = __builtin_nontemporal_load(fr_ + 64 * j); xx[u][j] = __builtin_nontemporal_load(xr + 64 * j);
                    v[u][j] = (f32x4){bfl(w.x), bfh(w.x), bfl(w.y), bfh(w.y)}; f[u][j] = (f32x4){bfl(q.x), bfh(q.x), bfl(q.y), bfh(q.y)}; } }
#pragma unroll
            for (int u = 0; u < 2; ++u)
#pragma unroll
                for (int j = 0; j < 4; ++j) { s[u] += (v[u][j].x * v[u][j].x + v[u][j].y * v[u][j].y) + (v[u][j].z * v[u][j].z + v[u][j].w * v[u][j].w); s3[u] += (f[u][j].x * f[u][j].x + f[u][j].y * f[u][j].y) + (f[u][j].z * f[u][j].z + f[u][j].w * f[u][j].w); }
#pragma unroll
            for (int u = 0; u < 2; ++u) { const float rstd = 1.0f / sqrtf(wave_sum(s[u]) * (1.0f / D) + EPS), rstd3 = 1.0f / sqrtf(wave_sum(s3[u]) * (1.0f / D) + EPS);
                f32x4* xo = (f32x4*)(a.out + (size_t)((m0 + u * NGW < T) ? m0 + u * NGW : m0) * D) + lane;
#pragma unroll
                for (int j = 0; j < 4; ++j) { const f32x4 g1 = ((const f32x4*)g_post_mix + lane)[64 * j], g3 = ((const f32x4*)g_post_ffn + lane)[64 * j];
                    __builtin_nontemporal_store((xx[u][j] + v[u][j] * rstd * g1) + f[u][j] * rstd3 * g3, xo + 64 * j); } }
        }
    }
}

extern "C" void kernel_launch(void* const* d_in, const int* in_sizes, int n_in, void* d_out, int out_size, void* d_ws, size_t ws_size, hipStream_t stream) {
    static int grid = 0;
    if (grid == 0) {
        if (n_in != 17 || in_sizes[0] != T * D || out_size != T * D || ws_size < 971 * MiB) { fprintf(stderr, "kernel_launch: unexpected shapes / workspace (n_in %d, in0 %d, out %d, ws %zu, need %zu)\n", n_in, n_in > 0 ? in_sizes[0] : -1, out_size, ws_size, (size_t)WS_END); grid = -1; return; }
        int dev = 0, cus = 0, per_cu = 0;
        hipGetDevice(&dev); hipDeviceGetAttribute(&cus, hipDeviceAttributeMultiprocessorCount, dev);
        if (hipFuncSetAttribute((const void*)fwd_megakernel, hipFuncAttributeMaxDynamicSharedMemorySize, LDS_BYTES) != hipSuccess) { fprintf(stderr, "kernel_launch: hipFuncSetAttribute failed\n"); grid = -1; return; }
        if (hipOccupancyMaxActiveBlocksPerMultiprocessor(&per_cu, (const void*)fwd_megakernel, NTHREADS, LDS_BYTES) != hipSuccess || per_cu < 1) { fprintf(stderr, "kernel_launch: occupancy query says %d blocks per CU\n", per_cu); per_cu = 1; }
        (void)hipGetLastError();
        grid = cus * 1;
    }
    if (grid < 0) return;
    Args a{};
    for (int i = 0; i < 17; ++i) a.in[i] = (const float*)d_in[i];
    a.out = (float*)d_out; a.ws = (unsigned char*)d_ws;
    void* args[] = {&a};
    hipError_t e = hipLaunchCooperativeKernel((const void*)fwd_megakernel, dim3(grid), dim3(NTHREADS), args, LDS_BYTES, stream);
    if (e != hipSuccess) fprintf(stderr, "kernel_launch: cooperative launch failed: %s (grid %d)\n", hipGetErrorString(e), grid);
}
```
